# Optimizing an MI355X kernel written in HIP

```python
import jax
import jax.numpy as jnp
from jax import lax
import numpy as np


D_MODEL = 1024
BATCH = 32
SEQ = 2048
DEPTH = 1

CHUNK = 64
Q_BLOCK = 128
A_HEADS = 8
A_HEAD_DIM = 64
A_KV_RANK = 128
IDX_HEADS = 8
IDX_DIM = 64
IDX_TOPK = 256
IDX_SCALE = (IDX_HEADS * IDX_DIM) ** -0.5
B_HEADS = 8
B_HEAD_DIM = 64
B_LEFT_CHUNKS = 8
B_BAND = (B_LEFT_CHUNKS + 1) * CHUNK
REL_CLIP = 128
N_EXPERTS = 32
TOP_K = 4
D_FF = 1024
SWIGLU_LIMIT = 7.0
SWIGLU_ALPHA = 1.702
EXPERT_BLOCK = 256
DN_ALPHA = (2.0 * DEPTH) ** 0.25
DN_BETA = (8.0 * DEPTH) ** -0.25
LN_EPS = 1e-5

A_WIDTH = A_HEADS * A_HEAD_DIM
B_WIDTH = B_HEADS * B_HEAD_DIM
SPLITS = [A_WIDTH, A_KV_RANK, IDX_HEADS * IDX_DIM, IDX_DIM, IDX_HEADS,
          B_WIDTH, B_WIDTH, B_WIDTH, D_MODEL, D_MODEL]
IN_WIDTH = sum(SPLITS)

kernel_name = 'streaming_hybrid_dsa_chunkband_moe_block'


def layer_norm(x, g, b):
    xf = x.astype(jnp.float32)
    mu = jnp.mean(xf, axis=-1, keepdims=True)
    var = jnp.mean(jnp.square(xf - mu), axis=-1, keepdims=True)
    return ((xf - mu) * lax.rsqrt(var + LN_EPS)).astype(x.dtype) * g + b


def rms_norm(x, g):
    xf = x.astype(jnp.float32)
    ms = jnp.mean(jnp.square(xf), axis=-1, keepdims=True)
    return (xf * lax.rsqrt(ms + LN_EPS)).astype(x.dtype) * g


def alibi_slopes(n_heads):
    return jnp.array([2.0 ** (-8.0 * (h + 1) / n_heads) for h in range(n_heads)], jnp.float32)


def sparse_indexed_attention(q, c_kv, q_idx, k_idx, w_idx, w_uk, w_uv):
    bsz, seq = q.shape[0], q.shape[1]
    topk = min(IDX_TOPK, seq // 4)
    nb = seq // Q_BLOCK
    scale = A_HEAD_DIM ** -0.5
    q_lat = jnp.einsum('bshd,hdr->bshr', q, w_uk)
    key_chunk = jnp.arange(seq) // CHUNK
    slopes = alibi_slopes(A_HEADS)

    def to_blocks(a):
        return a.reshape((bsz, nb, Q_BLOCK) + a.shape[2:]).swapaxes(0, 1)

    def block_fn(args):
        blk, qb, qib, wb = args
        qpos = blk * Q_BLOCK + jnp.arange(Q_BLOCK)
        qchunk = qpos // CHUNK
        admissible = key_chunk[None, :] <= qchunk[:, None]
        logits = jax.nn.relu(jnp.einsum('bthd,bsd->bths', qib, k_idx).astype(jnp.float32))
        iscore = jnp.einsum('bth,bths->bts', wb.astype(jnp.float32) * IDX_SCALE, logits)
        iscore = jnp.where(admissible[None], iscore, -jnp.inf)
        _, sel = lax.top_k(iscore, topk)
        kv_sel = jax.vmap(lambda c, i: c[i])(c_kv, sel)
        scores = jnp.einsum('bthr,btkr->bthk', qb, kv_sel).astype(jnp.float32) * scale
        dist = jnp.abs(qpos[None, :, None] - sel)
        scores = scores - slopes[None, None, :, None] * dist[:, :, None, :]
        valid = (sel // CHUNK) <= qchunk[None, :, None]
        scores = jnp.where(valid[:, :, None, :], scores, -jnp.inf)
        p = jax.nn.softmax(scores, axis=-1).astype(c_kv.dtype)
        return jnp.einsum('bthk,btkr->bthr', p, kv_sel)

    o_lat = lax.map(block_fn, (jnp.arange(nb), to_blocks(q_lat), to_blocks(q_idx), to_blocks(w_idx)))
    o_lat = o_lat.swapaxes(0, 1).reshape(bsz, seq, A_HEADS, A_KV_RANK)
    o = jnp.einsum('bshr,hrd->bshd', o_lat, w_uv)
    return o.reshape(bsz, seq, A_WIDTH)


def chunk_band_attention(q, k, v, rel_bias):
    bsz, seq = q.shape[0], q.shape[1]
    nc = seq // CHUNK
    pad = B_LEFT_CHUNKS * CHUNK
    scale = B_HEAD_DIM ** -0.5
    k_pad = jnp.pad(k, ((0, 0), (pad, 0), (0, 0), (0, 0)))
    v_pad = jnp.pad(v, ((0, 0), (pad, 0), (0, 0), (0, 0)))
    rel = jnp.arange(CHUNK)[:, None] - jnp.arange(B_BAND)[None, :] + pad
    bias = rel_bias[:, jnp.clip(rel, -REL_CLIP, REL_CLIP) + REL_CLIP].astype(jnp.float32)
    q_chunks = q.reshape(bsz, nc, CHUNK, B_HEADS, B_HEAD_DIM).swapaxes(0, 1)

    def chunk_fn(args):
        c, qc = args
        kb = lax.dynamic_slice_in_dim(k_pad, c * CHUNK, B_BAND, axis=1)
        vb = lax.dynamic_slice_in_dim(v_pad, c * CHUNK, B_BAND, axis=1)
        s = jnp.einsum('bqhd,bkhd->bhqk', qc, kb).astype(jnp.float32) * scale + bias[None]
        key_valid = (c * CHUNK - pad + jnp.arange(B_BAND)) >= 0
        s = jnp.where(key_valid[None, None, None, :], s, -jnp.inf)
        p = jax.nn.softmax(s, axis=-1).astype(vb.dtype)
        return jnp.einsum('bhqk,bkhd->bqhd', p, vb)

    o = lax.map(chunk_fn, (jnp.arange(nc), q_chunks))
    return o.swapaxes(0, 1).reshape(bsz, seq, B_WIDTH)


def moe_ffn(x, w_router, b_router, w_gate, b_gate, w_up, b_up, w_down, b_down):
    bsz, seq, d = x.shape
    n = bsz * seq
    xf = x.reshape(n, d)
    logits = (xf @ w_router + b_router).astype(jnp.float32)
    top_val, top_idx = lax.top_k(logits, TOP_K)
    gates = jax.nn.softmax(top_val, axis=-1)
    n_assign = n * TOP_K
    expert_flat = top_idx.reshape(-1)
    token_flat = jnp.repeat(jnp.arange(n, dtype=jnp.int32), TOP_K)
    gate_flat = gates.reshape(-1)
    order = jnp.argsort(expert_flat)
    e_s = expert_flat[order]
    t_s = token_flat[order]
    g_s = gate_flat[order]
    counts = jnp.bincount(expert_flat, length=N_EXPERTS).astype(jnp.int32)
    offsets = jnp.cumsum(counts) - counts
    padded = (counts + EXPERT_BLOCK - 1) // EXPERT_BLOCK * EXPERT_BLOCK
    padded_ends = jnp.cumsum(padded)
    padded_starts = padded_ends - padded
    dest = padded_starts[e_s] + jnp.arange(n_assign, dtype=jnp.int32) - offsets[e_s]
    nblk = -(-n_assign // EXPERT_BLOCK) + N_EXPERTS
    cap = nblk * EXPERT_BLOCK
    tok_buf = jnp.zeros((cap,), jnp.int32).at[dest].set(t_s)
    gate_buf = jnp.zeros((cap,), jnp.float32).at[dest].set(g_s)
    blk_start = jnp.arange(nblk, dtype=jnp.int32) * EXPERT_BLOCK
    blk_expert = jnp.minimum(jnp.searchsorted(padded_ends, blk_start, side='right'), N_EXPERTS - 1)

    def block_fn(args):
        e, tok, g = args
        xb = xf[tok]
        hg = jnp.minimum(xb @ w_gate[e] + b_gate[e], SWIGLU_LIMIT)
        hu = jnp.clip(xb @ w_up[e] + b_up[e], -SWIGLU_LIMIT, SWIGLU_LIMIT)
        h = (hu + 1.0) * (hg * jax.nn.sigmoid(SWIGLU_ALPHA * hg))
        y = h @ w_down[e] + b_down[e]
        return y * g[:, None].astype(y.dtype)

    y_buf = lax.map(block_fn, (blk_expert, tok_buf.reshape(nblk, EXPERT_BLOCK),
                               gate_buf.reshape(nblk, EXPERT_BLOCK)))
    y = jax.ops.segment_sum(y_buf.reshape(cap, d), tok_buf, num_segments=n)
    return y.reshape(bsz, seq, d)


def setup_inputs(seed: int = 0) -> dict:
    key = jax.random.key(seed)
    ks = jax.random.split(key, 24)
    f32 = jnp.float32
    nrm = lambda k, shape, s: jax.random.normal(k, shape, f32) * s
    bounds = np.cumsum([0] + SPLITS)
    col_scale = np.ones((IN_WIDTH,), np.float32)
    col_scale[bounds[7]:bounds[8]] = DN_BETA
    w_in = nrm(ks[1], (DEPTH, D_MODEL, IN_WIDTH), D_MODEL ** -0.5) * jnp.asarray(col_scale)
    return {
        'x': jax.random.normal(ks[0], (BATCH, SEQ, D_MODEL), f32),
        'w_in': w_in,
        'kv_norm_g': 1.0 + nrm(ks[2], (DEPTH, A_KV_RANK), 0.02),
        'idx_k_norm_g': 1.0 + nrm(ks[3], (DEPTH, IDX_DIM), 0.02),
        'idx_k_norm_b': nrm(ks[4], (DEPTH, IDX_DIM), 0.02),
        'w_uk': nrm(ks[5], (DEPTH, A_HEADS, A_HEAD_DIM, A_KV_RANK), A_KV_RANK ** -0.5),
        'w_uv': nrm(ks[6], (DEPTH, A_HEADS, A_KV_RANK, A_HEAD_DIM), DN_BETA * A_KV_RANK ** -0.5),
        'rel_bias': nrm(ks[7], (DEPTH, B_HEADS, 2 * REL_CLIP + 1), 0.1),
        'w_branch_a': nrm(ks[8], (DEPTH, A_WIDTH, D_MODEL), DN_BETA * A_WIDTH ** -0.5),
        'w_branch_b': nrm(ks[9], (DEPTH, B_WIDTH, D_MODEL), DN_BETA * B_WIDTH ** -0.5),
        'w_out': nrm(ks[10], (DEPTH, D_MODEL, D_MODEL), DN_BETA * D_MODEL ** -0.5),
        'ln1_g': 1.0 + nrm(ks[11], (DEPTH, D_MODEL), 0.02),
        'ln1_b': nrm(ks[12], (DEPTH, D_MODEL), 0.02),
        'w_router': nrm(ks[13], (DEPTH, D_MODEL, N_EXPERTS), D_MODEL ** -0.5),
        'b_router': nrm(ks[14], (DEPTH, N_EXPERTS), 0.01),
        'w_gate': nrm(ks[15], (DEPTH, N_EXPERTS, D_MODEL, D_FF), DN_BETA * D_MODEL ** -0.5),
        'b_gate': nrm(ks[16], (DEPTH, N_EXPERTS, D_FF), 0.01),
        'w_up': nrm(ks[17], (DEPTH, N_EXPERTS, D_MODEL, D_FF), DN_BETA * D_MODEL ** -0.5),
        'b_up': nrm(ks[18], (DEPTH, N_EXPERTS, D_FF), 0.01),
        'w_down': nrm(ks[19], (DEPTH, N_EXPERTS, D_FF, D_MODEL), DN_BETA * D_FF ** -0.5),
        'b_down': nrm(ks[20], (DEPTH, N_EXPERTS, D_MODEL), 0.01),
        'ln2_g': 1.0 + nrm(ks[21], (DEPTH, D_MODEL), 0.02),
        'ln2_b': nrm(ks[22], (DEPTH, D_MODEL), 0.02),
    }


def reference(x, w_in, kv_norm_g, idx_k_norm_g, idx_k_norm_b, w_uk, w_uv, rel_bias,
              w_branch_a, w_branch_b, w_out, ln1_g, ln1_b, w_router, b_router,
              w_gate, b_gate, w_up, b_up, w_down, b_down, ln2_g, ln2_b):
    bsz, seq, _ = x.shape
    split_at = np.cumsum(SPLITS)[:-1].tolist()
    for l in range(DEPTH):
        proj = jnp.einsum('bsd,de->bse', x, w_in[l])
        (qa, ckv, qi, ki, wi, qb, kb, vb, ga, gb) = jnp.split(proj, split_at, axis=-1)
        qa = qa.reshape(bsz, seq, A_HEADS, A_HEAD_DIM)
        ckv = rms_norm(ckv, kv_norm_g[l])
        qi = qi.reshape(bsz, seq, IDX_HEADS, IDX_DIM)
        ki = layer_norm(ki, idx_k_norm_g[l], idx_k_norm_b[l])
        y_a = sparse_indexed_attention(qa, ckv, qi, ki, wi, w_uk[l], w_uv[l])
        y_b = chunk_band_attention(qb.reshape(bsz, seq, B_HEADS, B_HEAD_DIM),
                                   kb.reshape(bsz, seq, B_HEADS, B_HEAD_DIM),
                                   vb.reshape(bsz, seq, B_HEADS, B_HEAD_DIM), rel_bias[l])
        merged = (jax.nn.sigmoid(ga) * (y_a @ w_branch_a[l])
                  + jax.nn.sigmoid(gb) * (y_b @ w_branch_b[l]))
        x = layer_norm(DN_ALPHA * x + merged @ w_out[l], ln1_g[l], ln1_b[l])
        ffn = moe_ffn(x, w_router[l], b_router[l], w_gate[l], b_gate[l], w_up[l], b_up[l],
                      w_down[l], b_down[l])
        x = layer_norm(DN_ALPHA * x + ffn, ln2_g[l], ln2_b[l])
    return x
```

```cpp
#include <hip/hip_runtime.h>
#include <cstdio>
#include <cstdint>

#ifndef MK_ONE_LAUNCH
#define MK_ONE_LAUNCH 1
#endif

#define GAS __attribute__((address_space(1)))
#define LAS __attribute__((address_space(3)))
typedef unsigned short bf16;
typedef unsigned v4u __attribute__((ext_vector_type(4)));
typedef unsigned v2u __attribute__((ext_vector_type(2)));
typedef float f32x4 __attribute__((ext_vector_type(4)));
typedef float f32x2 __attribute__((ext_vector_type(2)));
typedef float f32x16 __attribute__((ext_vector_type(16)));
typedef short bf16x8 __attribute__((ext_vector_type(8)));
#define RLX_AGENT __ATOMIC_RELAXED, __HIP_MEMORY_SCOPE_AGENT
#define LDS_WAIT() asm volatile("s_waitcnt lgkmcnt(0)" ::: "memory")
#define VM_WAIT() asm volatile("s_waitcnt vmcnt(0)" ::: "memory")

constexpr int NTOK = 65536, DM = 1024, NB = 32, SEQ = 2048;
constexpr int NE = 32, DFF = 1024;
constexpr int WIN_LD = 4808;
constexpr int PP = 5376;
constexpr int C_QLAT = 0, C_QI = 1024, C_T6 = 1536, C_QB = 1792, C_KB = 2304, C_VB = 2816, C_GA = 3328, C_GB = 4352;
constexpr int WR_QI = 0, WR_T6 = 512;
constexpr float LOG2E = 1.4426950408889634f;
constexpr float C2 = 0.125f * LOG2E;
constexpr float IDX_SCALE = 0.044194173824159216f;
constexpr float DN_ALPHA = 1.189207115002721f;
constexpr float LN_EPS = 1e-5f;
constexpr float NEG_BIG = -1e30f;

constexpr size_t MiB = 1u << 20;
constexpr size_t WS_CTL = 0, CTL_ZERO_BYTES = 1 * MiB;
constexpr size_t WS_WIN = 1 * MiB, WS_WUVA = 12 * MiB, WS_WB = 14 * MiB, WS_WOUT = 15 * MiB;
constexpr size_t WS_CKV = 17 * MiB, WS_CKVT = 33 * MiB, WS_KIDX = 49 * MiB, WS_WIDX = 57 * MiB, WS_VBT = 59 * MiB;
constexpr size_t WS_WING8 = 38 * MiB;
constexpr size_t WS_WUVA8 = 35 * MiB;
constexpr size_t WS_WB8 = 36 * MiB;
constexpr size_t WS_WOUT8 = 37 * MiB;
constexpr size_t WS_X8 = 59 * MiB;
constexpr size_t WS_OL8 = 928 * MiB;
constexpr size_t WS_YB8 = 992 * MiB;
constexpr float SC_WING = 32.f, SC_WUVA = 64.f, SC_WB = 32.f, SC_WOUT = 64.f, SC_YB = 16.f, SC_M = 8.f;
constexpr size_t WS_WUKT = 8 * MiB;
constexpr size_t WS_WRT = 11 * MiB + 512 * 1024;
constexpr size_t WS_PROJ = 128 * MiB;
constexpr size_t WS_XB = 800 * MiB;
constexpr size_t WS_PRE = 256 * MiB;
constexpr size_t WS_X1B = 768 * MiB;
constexpr size_t WS_CNT = 1 * MiB;
constexpr size_t WS_PST = 1 * MiB + 64 * 1024;
constexpr size_t WS_TE = 1 * MiB + 96 * 1024;
constexpr int NTE = 1088;
constexpr size_t WS_TOPE = 2 * MiB, WS_TOPG = 3 * MiB;
constexpr size_t WS_TOKS = 4 * MiB, WS_GATES = 6 * MiB, WS_SLOTS = 8 * MiB;
constexpr size_t WS_WGU = 16 * MiB;
constexpr size_t WS_WD = 80 * MiB;
constexpr size_t WS_X1Q = 112 * MiB;
constexpr size_t WS_H = 176 * MiB;
constexpr size_t WS_Y = 512 * MiB;
constexpr size_t WS_END = 1024 * MiB;
constexpr int HCAP_TILES = 1088;
constexpr int MAXROWS = (1024 + 32) * 256;
constexpr size_t WS_TRASH = 12 * MiB;
constexpr int TRASH_SLOT = -(int)((WS_Y - WS_TRASH) / 1024);
constexpr float SC_Y = 16.f;
constexpr int CW_TMO = 0, CW_ERR = 2;
constexpr int CW_BAR = 4096;

constexpr int RING_BYTES = 131072;
constexpr int LDS_BYTES = 147456;
constexpr int MISC_OFF = LDS_BYTES - 256;
constexpr int NV_LDS = RING_BYTES + 4096;
constexpr int EPG_LDS = RING_BYTES + 12288;
constexpr int TE_LDS = RING_BYTES + 1024;

__device__ __forceinline__ unsigned f2bf(float f) { unsigned u = __builtin_bit_cast(unsigned, f); return (u + 0x7fffu + ((u >> 16) & 1u)) >> 16; }
__device__ __forceinline__ unsigned pk2(float lo, float hi) { return f2bf(lo) | (f2bf(hi) << 16); }
typedef __bf16 bf16x2_t_ __attribute__((ext_vector_type(2)));
__device__ __forceinline__ unsigned cvt_pk_bf16(float lo, float hi) { f32x2 v = {lo, hi}; bf16x2_t_ b = __builtin_convertvector(v, bf16x2_t_); return __builtin_bit_cast(unsigned, b); }
__device__ __forceinline__ float bf_lo(unsigned w) { return __uint_as_float(w << 16); }
__device__ __forceinline__ float bf_hi(unsigned w) { return __uint_as_float(w & 0xffff0000u); }
__device__ __forceinline__ float sigmoidf_(float x) { return __builtin_amdgcn_rcpf(1.0f + __builtin_amdgcn_exp2f(-LOG2E * x)); }
template <int CTRL> __device__ __forceinline__ float dpp_f(float x) { return __builtin_bit_cast(float, __builtin_amdgcn_update_dpp(0, __builtin_bit_cast(int, x), CTRL, 0xF, 0xF, true)); }
__device__ __forceinline__ float swap16_sum(float d, float s_) { auto r = __builtin_amdgcn_permlane16_swap(__float_as_uint(d), __float_as_uint(s_), false, false); return __uint_as_float(r[0]) + __uint_as_float(r[1]); }
__device__ __forceinline__ float swap32_sum(float d, float s_) { auto r = __builtin_amdgcn_permlane32_swap(__float_as_uint(d), __float_as_uint(s_), false, false); return __uint_as_float(r[0]) + __uint_as_float(r[1]); }
__device__ __forceinline__ float wave_sum(float v) {
    v += dpp_f<0xB1>(v);
    v += dpp_f<0x4E>(v);
    v += dpp_f<0x141>(v);
    v += dpp_f<0x140>(v);
    v = swap16_sum(v, v);
    return swap32_sum(v, v);
}

__device__ __forceinline__ int lane_now() { int l; asm volatile("v_mbcnt_lo_u32_b32 %0, -1, 0\n\tv_mbcnt_hi_u32_b32 %0, -1, %0" : "=v"(l)); return l; }
namespace pg8 {
#define PG8_LAS __attribute__((address_space(3)))
typedef unsigned short bf16_t;
constexpr int BM = 256, BK = 64, HALF = 128, HTB = HALF * BK * 2, STAGE_BYTES = 8 * HTB, NXCD = 8, WGM = 8;
__host__ __device__ __forceinline__ int lds_byte(int r, int c) { const int st = (r >> 4) * 2 + (c >> 5), rr = r & 15, cc = c & 31, ob = rr * 64 + cc * 2; return st * 1024 + (ob ^ (((ob >> 9) & 1) << 5)); }
__host__ __device__ __forceinline__ void stage_rc(int b, int& R, int& C) { const int st = b / 1024, sb = b % 1024, swz = sb ^ (((sb >> 9) & 1) << 5); R = (st >> 1) * 16 + swz / 64; C = (st & 1) * 32 + (swz % 64) / 2; }
__host__ __device__ __forceinline__ int perm32(int rho) { const int n = rho >> 4, i = rho & 15; return 8 * (i >> 2) + 4 * n + (i & 3); }

struct Unit { int pm, pn, e, gt; const char* a; const char* b; const int* rows; };

__device__ __forceinline__ bool static_pmpn(int i, int G, int c, int nM, int nN, int& pm, int& pn) {
    i = __builtin_amdgcn_readfirstlane(i); const int nwg = nM * nN; const long L = (long)i * G + c; if (L >= nwg) return false;
    int wgid = (int)L; { const int q = nwg / NXCD, r = nwg % NXCD, xcd = wgid % NXCD, off = wgid / NXCD; wgid = (xcd < r ? xcd * (q + 1) : r * (q + 1) + (xcd - r) * q) + off; }
    const int nig = WGM * nN, gid = wgid / nig, fm = gid * WGM, gsz = (nM - fm) < WGM ? (nM - fm) : WGM;
    pm = __builtin_amdgcn_readfirstlane(fm + ((wgid % nig) % gsz)); pn = __builtin_amdgcn_readfirstlane((wgid % nig) / gsz); return true;
}
struct SchedDense {
    int nM, nN, G, c; const char* A; size_t a_t; const char* B; size_t b_t;
    __device__ __forceinline__ bool next(int i, Unit& u) const {
        int pm, pn; if (!static_pmpn(i, G, c, nM, nN, pm, pn)) return false;
        u.pm = pm; u.pn = pn; u.e = 0; u.gt = pm; u.a = A + (size_t)pm * a_t; u.b = B + (size_t)pn * b_t; u.rows = nullptr; return true;
    }
};
template <int NN, bool GATHERA> struct SchedMoe {
    int nM, tile0; const PG8_LAS unsigned char* te; const char* A; const char* B; const int* toks;
    static constexpr size_t B_E = (size_t)NN * 256 * 1024, B_T = (size_t)256 * 1024, A_T = (size_t)256 * 1024;
    __device__ __forceinline__ bool next(int i, Unit& u) const {
        int pm, pn; if (!static_pmpn(i, (int)gridDim.x, (int)blockIdx.x, nM, NN, pm, pn)) return false;
        const int gt = tile0 + pm; const int e = __builtin_amdgcn_readfirstlane((int)te[gt]);
        u.pm = pm; u.pn = pn; u.e = e; u.gt = gt; u.a = GATHERA ? A : A + (size_t)pm * A_T; u.b = B + (size_t)e * B_E + (size_t)pn * B_T; u.rows = toks + (size_t)gt * 256; return true;
    }
};

typedef int i32x8 __attribute__((ext_vector_type(8)));
constexpr float W8_SCALE = 64.0f, W8_INV = 1.0f / 64.0f;
__device__ __forceinline__ i32x8 cat8(const bf16x8& a, const bf16x8& b) { const v4u x = __builtin_bit_cast(v4u, a), y = __builtin_bit_cast(v4u, b); return (i32x8){(int)x.x, (int)x.y, (int)x.z, (int)x.w, (int)y.x, (int)y.y, (int)y.z, (int)y.w}; }
template <class Epi, class Sched, bool GATHER, bool FP8 = false, bool ALIGN_EPI = true>
__device__ __forceinline__ void gemm_phase(PG8_LAS unsigned char* lds, const int wid, const int Kb, const int ldab, const Sched& S, const Epi& E) {
    const int lane = lane_now(), tid = wid * 64 + lane, wr = wid >> 2, wc = wid & 3;
    const int nt = Kb / 128;
    const size_t kstep = (size_t)128;
    const size_t hstepB = (size_t)HALF * Kb;
    const unsigned ldsw = (unsigned)wid * 1024u;
#define PG8_LANE_OFFS() const int _ln = lane_now(); \
    const int aoff = lds_byte(wr * 64 + (_ln & 15), (_ln >> 4) * 8), boff = lds_byte(wc * 32 + (_ln & 15), (_ln >> 4) * 8); \
    unsigned voffB0; { int _R, _C; stage_rc((wid * 64 + _ln) * 16, _R, _C); const int _Rb = Epi::PERM ? ((_R & ~31) + perm32(_R & 31)) : _R; voffB0 = (unsigned)(_Rb * Kb + _C * 2); } \
    const unsigned voffB1 = voffB0 + 64u * (unsigned)Kb;
#define PG8_SA(b, h) (((b) * 2 + (h)) * HTB)
#define PG8_SB(b, h) ((4 + (b) * 2 + (h)) * HTB)
#define PG8_STAGE2(bufoff, gbase, v0, v1) do { \
        __builtin_amdgcn_global_load_lds((const unsigned*)((const char*)(gbase) + (v0)), (PG8_LAS unsigned*)(lds + (bufoff) + ldsw), 16, 0, 0); \
        __builtin_amdgcn_global_load_lds((const unsigned*)((const char*)(gbase) + (v1)), (PG8_LAS unsigned*)(lds + (bufoff) + ldsw + 8192), 16, 0, 0); } while (0)
#define PG8_STAGEB(bufoff, gbase) PG8_STAGE2(bufoff, gbase, voffB0, voffB1)
#define PG8_MKA(u, v) do { const int _tid = wid * 64 + lane_now(); _Pragma("unroll") for (int _i = 0; _i < 2; ++_i) { int _R, _C; stage_rc(_tid * 16 + _i * 8192, _R, _C); _Pragma("unroll") for (int _h = 0; _h < 2; ++_h) { \
        const int _row = _h * HALF + _R; const int _t = GATHER ? (u).rows[_row] : _row; v[_h][_i] = (unsigned)(_t * ldab + _C * 2); } } } while (0)
#define PG8_LDA(dst, b, h) do { _Pragma("unroll") for (int m = 0; m < 4; ++m) { const v4u _x = *(const PG8_LAS v4u*)(lds + PG8_SA(b, h) + aoff + m * 2048), _y = *(const PG8_LAS v4u*)(lds + PG8_SA(b, h) + aoff + m * 2048 + 1024); \
        dst[m] = (i32x8){(int)_x.x, (int)_x.y, (int)_x.z, (int)_x.w, (int)_y.x, (int)_y.y, (int)_y.z, (int)_y.w}; } } while (0)
#define PG8_LDB(dst, b, h) do { _Pragma("unroll") for (int n = 0; n < 2; ++n) { const v4u _x = *(const PG8_LAS v4u*)(lds + PG8_SB(b, h) + boff + n * 2048), _y = *(const PG8_LAS v4u*)(lds + PG8_SB(b, h) + boff + n * 2048 + 1024); \
        dst[n] = (i32x8){(int)_x.x, (int)_x.y, (int)_x.z, (int)_x.w, (int)_y.x, (int)_y.y, (int)_y.z, (int)_y.w}; } } while (0)
#define PG8_LO(v) __builtin_bit_cast(bf16x8, (v4u){(unsigned)(v)[0], (unsigned)(v)[1], (unsigned)(v)[2], (unsigned)(v)[3]})
#define PG8_HI(v) __builtin_bit_cast(bf16x8, (v4u){(unsigned)(v)[4], (unsigned)(v)[5], (unsigned)(v)[6], (unsigned)(v)[7]})
#define PG8_MMA(ai, bj, At, Bt) do { __builtin_amdgcn_s_setprio(1); \
        if constexpr (FP8) { _Pragma("unroll") for (int m = 0; m < 4; ++m) _Pragma("unroll") for (int n = 0; n < 2; ++n) \
            asm volatile("v_mfma_f32_16x16x128_f8f6f4 %0, %1, %2, %0" : "+v"(acc[ai][bj][m][n]) : "v"(Bt[n]), "v"(At[m])); } \
        else { _Pragma("unroll") for (int m = 0; m < 4; ++m) _Pragma("unroll") for (int n = 0; n < 2; ++n) { \
            acc[ai][bj][m][n] = __builtin_amdgcn_mfma_f32_16x16x32_bf16(PG8_LO(Bt[n]), PG8_LO(At[m]), acc[ai][bj][m][n], 0, 0, 0); \
            acc[ai][bj][m][n] = __builtin_amdgcn_mfma_f32_16x16x32_bf16(PG8_HI(Bt[n]), PG8_HI(At[m]), acc[ai][bj][m][n], 0, 0, 0); } } \
        __builtin_amdgcn_s_setprio(0); } while (0)
#define PG8_WAIT_V(n) asm volatile("s_waitcnt vmcnt(" #n ")" ::: "memory")
#define PG8_WAIT_L(n) asm volatile("s_waitcnt lgkmcnt(" #n ")" ::: "memory")
#define PG8_BAR __builtin_amdgcn_s_barrier()
#define PG8_SCHED __builtin_amdgcn_sched_barrier(0)
    Unit cur, nxt; int ui = 0;
    if (!S.next(0, cur)) return;
    f32x4 acc[2][2][4][2];
#pragma unroll
    for (int a = 0; a < 2; ++a)
#pragma unroll
        for (int b = 0; b < 2; ++b)
#pragma unroll
            for (int m = 0; m < 4; ++m)
#pragma unroll
                for (int n = 0; n < 2; ++n) acc[a][b][m][n] = (f32x4){0.f, 0.f, 0.f, 0.f};
    i32x8 At[4], B0[2], B1[2];
    unsigned vA[2][2];
    PG8_MKA(cur, vA);
    const char* cA = cur.a; const char* cB = cur.b;
    { PG8_LANE_OFFS(); (void)aoff; (void)boff;
    PG8_STAGEB(PG8_SB(0, 0), cB); PG8_STAGEB(PG8_SB(0, 1), cB + hstepB); PG8_STAGE2(PG8_SA(0, 0), cA, vA[0][0], vA[0][1]); PG8_STAGE2(PG8_SA(0, 1), cA, vA[1][0], vA[1][1]);
    if (wr == 1) PG8_BAR;
    PG8_WAIT_V(2); PG8_BAR;
    PG8_STAGEB(PG8_SB(1, 0), cB + kstep); PG8_STAGE2(PG8_SA(1, 0), cA + kstep, vA[0][0], vA[0][1]); PG8_STAGEB(PG8_SB(1, 1), cB + hstepB + kstep);
    PG8_WAIT_V(6); PG8_BAR; }
    for (;;) {
        const bool has_next = S.next(ui + 1, nxt);
        if constexpr (Epi::HAS_PF) E.prefetch(lds, cur, wid, ui & 1);
        if (GATHER) { if (has_next) {
            __builtin_amdgcn_global_load_lds((const unsigned*)(nxt.rows + 4 * lane_now()), (PG8_LAS unsigned*)(lds + NV_LDS + wid * 1024), 16, 0, 0); } }
        const char* nA = has_next ? nxt.a : cA; const char* nB = has_next ? nxt.b : cB;
#pragma clang loop unroll(disable)
        for (int t = 0; t < nt; t += 2) {
            const bool last = (t == nt - 2);
            PG8_LANE_OFFS();
            const char* a1 = cA + (size_t)(t + 1) * kstep;
            const char* a2 = last ? nA : cA + (size_t)(t + 2) * kstep; const char* b2 = last ? nB : cB + (size_t)(t + 2) * kstep;
            const char* a3 = a2 + kstep; const char* b3 = b2 + kstep;
            PG8_LDB(B0, 0, 0); PG8_LDB(B1, 0, 1); PG8_SCHED; PG8_LDA(At, 0, 0); PG8_STAGE2(PG8_SA(1, 1), a1, vA[1][0], vA[1][1]);
            PG8_WAIT_V(8); PG8_WAIT_L(0); PG8_BAR; PG8_MMA(0, 0, At, B0); PG8_MMA(0, 1, At, B1); PG8_BAR; PG8_SCHED;
            if (GATHER) { if (last && has_next) {
                int _R, _C; stage_rc((wid * 64 + _ln) * 16, _R, _C); const PG8_LAS int* _tk = (const PG8_LAS int*)(lds + NV_LDS + wid * 1024);
                vA[0][0] = (unsigned)(_tk[_R] * ldab + _C * 2); vA[0][1] = (unsigned)(_tk[_R + 64] * ldab + _C * 2); vA[1][0] = (unsigned)(_tk[HALF + _R] * ldab + _C * 2); vA[1][1] = (unsigned)(_tk[HALF + _R + 64] * ldab + _C * 2); } }
            PG8_LDA(At, 0, 1); PG8_STAGEB(PG8_SB(0, 0), b2); PG8_STAGEB(PG8_SB(0, 1), b2 + hstepB); PG8_STAGE2(PG8_SA(0, 0), a2, vA[0][0], vA[0][1]);
            PG8_WAIT_V(8); PG8_WAIT_L(0); PG8_BAR; PG8_MMA(1, 0, At, B0); PG8_MMA(1, 1, At, B1); PG8_BAR; PG8_SCHED;
            PG8_LDB(B0, 1, 0); PG8_LDB(B1, 1, 1); PG8_SCHED; PG8_LDA(At, 1, 0); PG8_STAGE2(PG8_SA(0, 1), a2, vA[1][0], vA[1][1]);
            PG8_WAIT_V(8); PG8_WAIT_L(0); PG8_BAR; PG8_MMA(0, 0, At, B0); PG8_MMA(0, 1, At, B1); PG8_BAR; PG8_SCHED;
            PG8_LDA(At, 1, 1); PG8_STAGEB(PG8_SB(1, 0), b3); PG8_STAGEB(PG8_SB(1, 1), b3 + hstepB); PG8_STAGE2(PG8_SA(1, 0), a3, vA[0][0], vA[0][1]);
            PG8_WAIT_V(8); PG8_WAIT_L(0); PG8_BAR; PG8_MMA(1, 0, At, B0); PG8_MMA(1, 1, At, B1); PG8_BAR; PG8_SCHED;
        }
        if constexpr (ALIGN_EPI) { if (wr == 0) PG8_BAR; }
        if constexpr (FP8) asm volatile("s_nop 15\n\ts_nop 15" ::: "memory");
        if constexpr (Epi::HAS_PF) E(acc, cur, wr, wc, lds, ui & 1); else E(acc, cur, wr, wc);
        if (!has_next) break;
#pragma unroll
        for (int a = 0; a < 2; ++a)
#pragma unroll
            for (int b = 0; b < 2; ++b)
#pragma unroll
                for (int m = 0; m < 4; ++m)
#pragma unroll
                    for (int n = 0; n < 2; ++n) acc[a][b][m][n] = (f32x4){0.f, 0.f, 0.f, 0.f};
        cur = nxt; cA = nA; cB = nB; ++ui;
        if constexpr (ALIGN_EPI) { if (wr == 1) PG8_BAR; }
    }
    PG8_WAIT_V(0);
    if constexpr (!ALIGN_EPI) { if (wr == 0) PG8_BAR; }
    PG8_BAR;
#undef PG8_SA
#undef PG8_SB
#undef PG8_STAGE2
#undef PG8_STAGEB
#undef PG8_MKA
#undef PG8_LANE_OFFS
#undef PG8_LDA
#undef PG8_LDB
#undef PG8_MMA
#undef PG8_LO
#undef PG8_HI
#undef PG8_WAIT_V
#undef PG8_WAIT_L
#undef PG8_BAR
#undef PG8_SCHED
}

__device__ __forceinline__ unsigned pk4_fp8(float a, float b, float c, float d) { unsigned w = 0; w = __builtin_amdgcn_cvt_pk_fp8_f32(a, b, w, false); w = __builtin_amdgcn_cvt_pk_fp8_f32(c, d, w, true); return w; }
struct EpiProj {
    static constexpr bool PERM = true; static constexpr bool HAS_PF = false;
    bf16_t* proj; float* r6;
    __device__ __forceinline__ void operator()(const f32x4 (&acc)[2][2][4][2], const Unit& u, int wr, int wc) const {
        const int lane__ = lane_now(), fr = lane__ & 15, fq = lane__ >> 4;
        const int row0 = u.pm * BM + wr * 64 + fr; const int colt = C_QI + u.pn * BM + wc * 32 + 8 * fq;
        if (u.pn == 2) {
#pragma unroll
            for (int ai = 0; ai < 2; ++ai)
#pragma unroll
                for (int m = 0; m < 4; ++m) { float* rowp = r6 + (size_t)(row0 + ai * HALF + m * 16) * 256 + wc * 32 + 8 * fq;
#pragma unroll
                    for (int bj = 0; bj < 2; ++bj) { *(f32x4*)(rowp + bj * HALF) = acc[ai][bj][m][0]; *(f32x4*)(rowp + bj * HALF + 4) = acc[ai][bj][m][1]; } }
            return;
        }
#pragma unroll
        for (int ai = 0; ai < 2; ++ai)
#pragma unroll
            for (int m = 0; m < 4; ++m) { bf16_t* rowp = proj + (size_t)(row0 + ai * HALF + m * 16) * PP + colt;
#pragma unroll
                for (int bj = 0; bj < 2; ++bj) { f32x4 v0 = acc[ai][bj][m][0], v1 = acc[ai][bj][m][1];
                    v4u w; w.x = cvt_pk_bf16(v0[0], v0[1]); w.y = cvt_pk_bf16(v0[2], v0[3]); w.z = cvt_pk_bf16(v1[0], v1[1]); w.w = cvt_pk_bf16(v1[2], v1[3]);
                    *(v4u*)(rowp + bj * HALF) = w; } }
    }
};
constexpr int GATE8_OFF = 2 * C_GA;
struct EpiGate8 {
    static constexpr bool PERM = true; static constexpr bool HAS_PF = false;
    bf16_t* proj;
    __device__ __forceinline__ void operator()(const f32x4 (&acc)[2][2][4][2], const Unit& u, int wr, int wc) const {
        const int lane__ = lane_now(), fr = lane__ & 15, fq = lane__ >> 4;
        const bool isq = u.pn >= 14;
        const int row0 = u.pm * BM + wr * 64 + fr; const int colt = (isq ? C_QLAT + (u.pn - 14) * BM : C_QB + u.pn * BM) + wc * 32 + 8 * fq;
        const bool sg = u.pn >= 6 && !isq; const float sc = (u.pn < 2) ? C2 / SC_WING : 1.0f / SC_WING;
#pragma unroll
        for (int ai = 0; ai < 2; ++ai)
#pragma unroll
            for (int m = 0; m < 4; ++m) { bf16_t* rowp = proj + (size_t)(row0 + ai * HALF + m * 16) * PP + colt;
#pragma unroll
                for (int bj = 0; bj < 2; ++bj) { f32x4 v0 = acc[ai][bj][m][0] * sc, v1 = acc[ai][bj][m][1] * sc;
                    if (sg) {
                        unsigned b0[4], b1[4];
#pragma unroll
                        for (int j = 0; j < 4; ++j) { b0[j] = (unsigned)(sigmoidf_(v0[j]) * 255.f + 0.5f); b1[j] = (unsigned)(sigmoidf_(v1[j]) * 255.f + 0.5f); }
                        v2u w; w.x = b0[0] | (b0[1] << 8) | (b0[2] << 16) | (b0[3] << 24); w.y = b1[0] | (b1[1] << 8) | (b1[2] << 16) | (b1[3] << 24);
                        *(v2u*)((unsigned char*)proj + (size_t)(row0 + ai * HALF + m * 16) * (PP * 2) + GATE8_OFF + (u.pn - 6) * BM + wc * 32 + 8 * fq + bj * HALF) = w;
                    } else {
                        v4u w; w.x = cvt_pk_bf16(v0[0], v0[1]); w.y = cvt_pk_bf16(v0[2], v0[3]); w.z = cvt_pk_bf16(v1[0], v1[1]); w.w = cvt_pk_bf16(v1[2], v1[3]);
                        *(v4u*)(rowp + bj * HALF) = w; } } }
    }
};
template <bool ADD> struct EpiMerge {
    static constexpr bool PERM = true; static constexpr bool HAS_PF = false;
    const unsigned char* gate; bf16_t* tb; unsigned char* m8;
    __device__ __forceinline__ void operator()(const f32x4 (&acc)[2][2][4][2], const Unit& u, int wr, int wc) const {
        const int lane__ = lane_now(), fr = lane__ & 15, fq = lane__ >> 4;
        const int row0 = u.pm * BM + wr * 64 + fr; const int colt = u.pn * BM + wc * 32 + 8 * fq;
        const float sc = (ADD ? 1.0f / (SC_YB * SC_WB) : 1.0f / SC_WUVA) * (1.0f / 255.f);
#pragma unroll
        for (int ai = 0; ai < 2; ++ai)
#pragma unroll
            for (int m = 0; m < 4; ++m) { const size_t row = (size_t)(row0 + ai * HALF + m * 16);
#pragma unroll
                for (int bj = 0; bj < 2; ++bj) { const v2u g = *(const v2u*)(gate + row * (PP * 2) + colt + bj * HALF);
                    f32x4 v0 = acc[ai][bj][m][0] * sc, v1 = acc[ai][bj][m][1] * sc;
                    v0[0] *= (float)(g.x & 0xffu); v0[1] *= (float)((g.x >> 8) & 0xffu); v0[2] *= (float)((g.x >> 16) & 0xffu); v0[3] *= (float)(g.x >> 24);
                    v1[0] *= (float)(g.y & 0xffu); v1[1] *= (float)((g.y >> 8) & 0xffu); v1[2] *= (float)((g.y >> 16) & 0xffu); v1[3] *= (float)(g.y >> 24);
                    unsigned char* tp = (unsigned char*)tb + row * (PP * 2) + colt + bj * HALF;
                    if (ADD) { const v2u t = *(const v2u*)tp;
                        const f32x2 t0 = __builtin_amdgcn_cvt_pk_f32_fp8(t.x, false), t1 = __builtin_amdgcn_cvt_pk_f32_fp8(t.x, true), t2 = __builtin_amdgcn_cvt_pk_f32_fp8(t.y, false), t3 = __builtin_amdgcn_cvt_pk_f32_fp8(t.y, true);
                        v0[0] = v0[0] * SC_M + t0[0]; v0[1] = v0[1] * SC_M + t0[1]; v0[2] = v0[2] * SC_M + t1[0]; v0[3] = v0[3] * SC_M + t1[1];
                        v1[0] = v1[0] * SC_M + t2[0]; v1[1] = v1[1] * SC_M + t2[1]; v1[2] = v1[2] * SC_M + t3[0]; v1[3] = v1[3] * SC_M + t3[1];
                        v2u w; w.x = pk4_fp8(v0[0], v0[1], v0[2], v0[3]); w.y = pk4_fp8(v1[0], v1[1], v1[2], v1[3]);
                        *(v2u*)(m8 + row * 1024 + colt + bj * HALF) = w;
                    } else {
                        v2u w; w.x = pk4_fp8(v0[0] * SC_M, v0[1] * SC_M, v0[2] * SC_M, v0[3] * SC_M); w.y = pk4_fp8(v1[0] * SC_M, v1[1] * SC_M, v1[2] * SC_M, v1[3] * SC_M);
                        *(v2u*)tp = w; } } }
    }
};
struct EpiOut {
    static constexpr bool PERM = true; static constexpr bool HAS_PF = false;
    const bf16_t* xb; bf16_t* pre;
    __device__ __forceinline__ void operator()(const f32x4 (&acc)[2][2][4][2], const Unit& u, int wr, int wc) const {
        const int lane__ = lane_now(), fr = lane__ & 15, fq = lane__ >> 4;
        const int row0 = u.pm * BM + wr * 64 + fr; const int colt = u.pn * BM + wc * 32 + 8 * fq;
        const float sc = 1.0f / (SC_M * SC_WOUT);
#pragma unroll
        for (int ai = 0; ai < 2; ++ai)
#pragma unroll
            for (int m = 0; m < 4; ++m) { const size_t row = (size_t)(row0 + ai * HALF + m * 16);
#pragma unroll
                for (int bj = 0; bj < 2; ++bj) { const v4u g = *(const v4u*)(xb + row * 1024 + colt + bj * HALF);
                    f32x4 v0 = acc[ai][bj][m][0] * sc, v1 = acc[ai][bj][m][1] * sc;
                    v0[0] += DN_ALPHA * bf_lo(g.x); v0[1] += DN_ALPHA * bf_hi(g.x); v0[2] += DN_ALPHA * bf_lo(g.y); v0[3] += DN_ALPHA * bf_hi(g.y);
                    v1[0] += DN_ALPHA * bf_lo(g.z); v1[1] += DN_ALPHA * bf_hi(g.z); v1[2] += DN_ALPHA * bf_lo(g.w); v1[3] += DN_ALPHA * bf_hi(g.w);
                    v4u w; w.x = cvt_pk_bf16(v0[0], v0[1]); w.y = cvt_pk_bf16(v0[2], v0[3]); w.z = cvt_pk_bf16(v1[0], v1[1]); w.w = cvt_pk_bf16(v1[2], v1[3]);
                    *(v4u*)(pre + row * 1024 + colt + bj * HALF) = w; } }
    }
};
__device__ __forceinline__ v4u widen16(v2u a, v2u b) {
    const auto rx = __builtin_amdgcn_permlane16_swap(a.x, b.x, false, false), ry = __builtin_amdgcn_permlane16_swap(a.y, b.y, false, false);
    return (v4u){rx[0], ry[0], rx[1], ry[1]};
}
struct EpiGU {
    static constexpr bool PERM = true; static constexpr bool HAS_PF = true;
    const float* bg; const float* bu; unsigned char* hbuf;
    __device__ __forceinline__ void prefetch(PG8_LAS unsigned char* lds, const Unit& u, int wid, int par) const {
        if (wid == 0) { const int l = lane_now(); const float* src = ((l < 32) ? bg : bu) + u.e * DFF + u.pn * HALF + 4 * (l & 31);
            __builtin_amdgcn_global_load_lds((const unsigned*)src, (PG8_LAS unsigned*)(lds + EPG_LDS + par * 1024), 16, 0, 0); }
    }
    __device__ __forceinline__ void operator()(const f32x4 (&acc)[2][2][4][2], const Unit& u, int wr, int wc, PG8_LAS unsigned char* lds, int par) const {
        const int lane__ = lane_now(), fr = lane__ & 15, fq = lane__ >> 4;
        const int ff0 = u.pn * HALF + wc * 32 + 8 * fq;
        const PG8_LAS float* bl = (const PG8_LAS float*)(lds + EPG_LDS + par * 1024) + wc * 32 + 8 * fq;
        const f32x4 g0 = *(const PG8_LAS f32x4*)bl, g1 = *(const PG8_LAS f32x4*)(bl + 4), u0 = *(const PG8_LAS f32x4*)(bl + 128), u1 = *(const PG8_LAS f32x4*)(bl + 132);
#pragma unroll
        for (int ai = 0; ai < 2; ++ai)
#pragma unroll
            for (int mp = 0; mp < 4; mp += 2) { v2u w2[2];
#pragma unroll
                for (int mm = 0; mm < 2; ++mm) { const int m = mp + mm;
                    float hv[8];
#pragma unroll
                    for (int n = 0; n < 2; ++n) { const f32x4 gv = acc[ai][0][m][n] * W8_INV + (n ? g1 : g0), uv = acc[ai][1][m][n] * W8_INV + (n ? u1 : u0);
#pragma unroll
                        for (int j = 0; j < 4; ++j) { const float hg = fminf(gv[j], 7.0f), hu = fminf(fmaxf(uv[j], -7.0f), 7.0f); hv[4 * n + j] = (hu + 1.0f) * (hg * sigmoidf_(1.702f * hg)); } }
                    w2[mm].x = pk4_fp8(hv[0], hv[1], hv[2], hv[3]); w2[mm].y = pk4_fp8(hv[4], hv[5], hv[6], hv[7]); }
                const size_t row = (size_t)(u.pm * BM + ai * HALF + wr * 64 + (mp + (fq & 1)) * 16 + fr);
                *(v4u*)(hbuf + row * 1024 + (ff0 - 8 * (fq & 1))) = widen16(w2[0], w2[1]); }
    }
};
struct EpiDown {
    static constexpr bool PERM = true; static constexpr bool HAS_PF = true;
    const float* bd; const float* gates; const int* slots; unsigned char* ybuf;
    __device__ __forceinline__ void prefetch(PG8_LAS unsigned char* lds, const Unit& u, int wid, int par) const {
        if (wid < 2) { const void* src = (wid == 0) ? (const void*)(slots + (size_t)u.gt * 256 + 4 * lane_now()) : (const void*)(gates + (size_t)u.gt * 256 + 4 * lane_now());
            __builtin_amdgcn_global_load_lds((const unsigned*)src, (PG8_LAS unsigned*)(lds + NV_LDS + par * 2048 + wid * 1024), 16, 0, 0); }
    }
    __device__ __forceinline__ void operator()(const f32x4 (&acc)[2][2][4][2], const Unit& u, int wr, int wc, PG8_LAS unsigned char* lds, int par) const {
        const int lane__ = lane_now(), fr = lane__ & 15, fq = lane__ >> 4;
        const int colt = u.pn * BM + wc * 32 + 8 * fq;
        int slot2[2][2]; float gte[2][4];
        const PG8_LAS int* sl = (const PG8_LAS int*)(lds + NV_LDS + par * 2048); const PG8_LAS float* gl = (const PG8_LAS float*)(lds + NV_LDS + par * 2048 + 1024);
#pragma unroll
        for (int ai = 0; ai < 2; ++ai) {
#pragma unroll
            for (int m = 0; m < 4; ++m) gte[ai][m] = gl[ai * HALF + wr * 64 + m * 16 + fr] * SC_Y;
#pragma unroll
            for (int mh = 0; mh < 2; ++mh) slot2[ai][mh] = sl[ai * HALF + wr * 64 + (2 * mh + (fq & 1)) * 16 + fr]; }
        f32x4 bv[2][2];
#pragma unroll
        for (int bj = 0; bj < 2; ++bj) { bv[bj][0] = *(const f32x4*)(bd + u.e * DM + colt + bj * HALF); bv[bj][1] = *(const f32x4*)(bd + u.e * DM + colt + bj * HALF + 4); }
#pragma unroll
        for (int ai = 0; ai < 2; ++ai)
#pragma unroll
            for (int mp = 0; mp < 4; mp += 2) { const long myslot = slot2[ai][mp >> 1];
#pragma unroll
                for (int bj = 0; bj < 2; ++bj) { v2u w2[2];
#pragma unroll
                    for (int mm = 0; mm < 2; ++mm) { const int m = mp + mm; const float gt = gte[ai][m];
                        const f32x4 v0 = (acc[ai][bj][m][0] * W8_INV + bv[bj][0]) * gt, v1 = (acc[ai][bj][m][1] * W8_INV + bv[bj][1]) * gt;
                        w2[mm].x = pk4_fp8(v0[0], v0[1], v0[2], v0[3]); w2[mm].y = pk4_fp8(v1[0], v1[1], v1[2], v1[3]); }
                    *(v4u*)(ybuf + myslot * 1024 + (colt - 8 * (fq & 1)) + bj * HALF) = widen16(w2[0], w2[1]); } }
    }
};
}

#define XB_TMO      128
#define XB_XCNT(j)  (256  + 64 * (j))
#define XB_XSUB(j)  (1280 + 64 * (j))
#define XB_XGEN(j)  (2304 + 64 * (j))
#define XB_TOP      3328
#define XB_TOPGEN   3392
#define XCD_BAR_WORDS 3456
#define XB_SPIN_CAP (1u << 18)

__device__ __forceinline__ unsigned xb_ld(unsigned* p)              { return __hip_atomic_load(p, __ATOMIC_RELAXED, __HIP_MEMORY_SCOPE_AGENT); }
__device__ __forceinline__ unsigned xb_add(unsigned* p, unsigned v) { return __hip_atomic_fetch_add(p, v, __ATOMIC_RELAXED, __HIP_MEMORY_SCOPE_AGENT); }
__device__ __forceinline__ unsigned xb_xcc_id() { return (unsigned)__builtin_amdgcn_s_getreg((3 << 11) | 20) & 0xFu; }
#define XB_SPIN(cond, bar) do { unsigned _sp = 0; while (cond) { __builtin_amdgcn_s_sleep(1); \
    if ((++_sp & 255u) == 0u) { if (xb_ld(&(bar)[XB_TMO])) break; if (_sp > XB_SPIN_CAP) { atomicAdd(&(bar)[XB_TMO], 1u); break; } } } } while (0)

struct XcdBarrier { unsigned* bar; unsigned x; volatile LAS unsigned* st; };

__device__ __forceinline__ XcdBarrier xcd_barrier_post(unsigned* bar, volatile LAS unsigned* st) {
    XcdBarrier b; b.bar = bar; b.x = xb_xcc_id(); b.st = st;
    if (threadIdx.x == 0) (void)xb_add(&bar[XB_XCNT(b.x)], 1u);
    return b;
}
__device__ __forceinline__ void xcd_barrier_complete(unsigned* bar, unsigned x, unsigned& nloc, unsigned& nx) {
    const unsigned G = gridDim.x * gridDim.y * gridDim.z;
    unsigned sum, cnt, mine, sp = 0u;
    for (;;) {
        sum = 0u; cnt = 0u; mine = 0u;
#pragma unroll
        for (unsigned j = 0; j < 16; ++j) { const unsigned c = xb_ld(&bar[XB_XCNT(j)]); sum += c; cnt += (c > 0u) ? 1u : 0u; mine = (j == x) ? c : mine; }
        if (sum == G) break;
        __builtin_amdgcn_s_sleep(1);
        if ((++sp & 255u) == 0u) { if (xb_ld(&bar[XB_TMO])) break; if (sp > XB_SPIN_CAP) { atomicAdd(&bar[XB_TMO], 1u); break; } }
    }
    nloc = mine > 0u ? mine : 1u; nx = cnt > 0u ? cnt : 1u;
}
__device__ __forceinline__ void xcd_barrier(const XcdBarrier& b) {
    asm volatile("s_waitcnt vmcnt(0)" ::: "memory");
    __syncthreads();
    if (threadIdx.x == 0) {
        unsigned* bar = b.bar;
        __builtin_amdgcn_s_waitcnt(0);
        unsigned nloc = b.st[0], nx = b.st[1];
        if (nloc == 0u) { xcd_barrier_complete(bar, b.x, nloc, nx); b.st[0] = nloc; b.st[1] = nx; }
        const unsigned old = xb_add(&bar[XB_XSUB(b.x)], 1u);
        const unsigned gen = old / nloc;
        if (old + 1u == (gen + 1u) * nloc) {
            __builtin_amdgcn_fence(__ATOMIC_RELEASE, "agent");
            asm volatile("s_waitcnt vmcnt(0)" ::: "memory");
            const unsigned og = xb_add(&bar[XB_TOP], 1u);
            const unsigned tg = og / nx;
            if (og + 1u == (tg + 1u) * nx) xb_add(&bar[XB_TOPGEN], 1u);
            else XB_SPIN(xb_ld(&bar[XB_TOPGEN]) == tg, bar);
            __builtin_amdgcn_fence(__ATOMIC_ACQUIRE, "agent");
            xb_add(&bar[XB_XGEN(b.x)], 1u);
            asm volatile("s_waitcnt vmcnt(0)" ::: "memory");
        } else {
            XB_SPIN(xb_ld(&bar[XB_XGEN(b.x)]) == gen, bar);
            __builtin_amdgcn_fence(__ATOMIC_ACQUIRE, "agent");
            asm volatile("s_waitcnt vmcnt(0)" ::: "memory");
        }
    }
    __syncthreads();
}

struct Args { const float* in[23]; float* out; unsigned char* ws; int ph_lo, ph_hi, li, pad; };
enum { I_X = 0, I_WIN, I_KVG, I_KIG, I_KIB, I_WUK, I_WUV, I_RELB, I_WA, I_WBR, I_WOUT, I_LN1G, I_LN1B, I_WR, I_BR, I_WG, I_BG, I_WU, I_BU, I_WD, I_BD, I_LN2G, I_LN2B };

struct Frame {
    LAS unsigned char* lds;
    unsigned* ctl;
    int tid, lane, wave, vcu, G;
    unsigned char* ws;
};

__device__ __forceinline__ void transpose_item(const float* W, int ldw, int col0, bf16* WT, int K, int row0, float scale, LAS float* scr, int kb, int nb, int lane) {
    const int k0 = 64 * kb, n0 = 32 * nb;
#pragma unroll 8
    for (int i = 0; i < 32; ++i) { const int kk = 2 * i + (lane >> 5); scr[kk * 33 + (lane & 31)] = W[(size_t)(k0 + kk) * ldw + col0 + n0 + (lane & 31)] * scale; }
    LDS_WAIT(); asm volatile("" ::: "memory");
    const int c = lane & 7;
#pragma unroll
    for (int j = 0; j < 4; ++j) { const int n = (lane >> 3) + 8 * j; const LAS float* s = scr + (8 * c) * 33 + n;
        v4u o; o.x = pk2(s[0 * 33], s[1 * 33]); o.y = pk2(s[2 * 33], s[3 * 33]); o.z = pk2(s[4 * 33], s[5 * 33]); o.w = pk2(s[6 * 33], s[7 * 33]);
        *(v4u*)(WT + (size_t)(row0 + n0 + n) * K + k0 + 8 * c) = o; }
    LDS_WAIT(); asm volatile("" ::: "memory");
}

__device__ __forceinline__ void transpose_item8(const float* W, int ldw, int col0, unsigned char* WT, int K, int row0, float scale, LAS float* scr, int kb, int lane) {
    const int k0 = 64 * kb, l3 = lane >> 3, n4 = (lane & 7) * 4;
    f32x4 v[8];
#pragma unroll
    for (int i = 0; i < 8; ++i) v[i] = *(const f32x4*)(W + (size_t)(k0 + l3 + 8 * i) * ldw + col0 + n4);
#pragma unroll
    for (int i = 0; i < 8; ++i)
#pragma unroll
        for (int j = 0; j < 4; ++j) scr[(n4 + j) * 65 + l3 + 8 * i] = v[i][j] * scale;
    LDS_WAIT(); asm volatile("" ::: "memory");
    const int c = lane & 7;
#pragma unroll
    for (int jn = 0; jn < 4; ++jn) { const int n = l3 + 8 * jn; const LAS float* s = scr + n * 65 + 8 * c;
        v2u o; o.x = pg8::pk4_fp8(s[0], s[1], s[2], s[3]); o.y = pg8::pk4_fp8(s[4], s[5], s[6], s[7]);
        *(v2u*)(WT + (size_t)(row0 + n) * K + k0 + 8 * c) = o; }
    LDS_WAIT(); asm volatile("" ::: "memory");
}

__device__ __forceinline__ void p0_prologue(Frame& F, const Args& A) {
    const float* w_in = A.in[I_WIN];
    bf16* Win_t = (bf16*)(F.ws + WS_WIN);
    const int gw = F.vcu * 8 + F.wave, NGW = F.G * 8;
    for (int job = 64 + blockIdx.x; job < 128; job += F.G) {
        LAS float* L1 = (LAS float*)F.lds;
        LAS float* L2 = (LAS float*)(F.lds + 32768);
        const int jj = job & 63, h = jj >> 3, blk = jj & 7;
        const int tx = F.tid & 127, rg = F.tid >> 7;
        if (job < 64) {
            const float* uk = A.in[I_WUK] + (size_t)h * 64 * 128;
            for (int i = F.tid; i < 8192; i += 512) L1[i] = uk[i];
            for (int i = F.tid; i < 8192; i += 512) { const int kk = i >> 6, d = i & 63; L2[d * 129 + kk] = w_in[(size_t)(blk * 128 + kk) * WIN_LD + h * 64 + d]; }
        } else {
            const float* uv = A.in[I_WUV] + (size_t)h * 128 * 64;
            for (int i = F.tid; i < 8192; i += 512) { const int r = i >> 6, d = i & 63; L1[d * 128 + r] = uv[i]; }
            const float* wa = A.in[I_WA];
            for (int i = F.tid; i < 8192; i += 512) { const int d = i >> 7, nn = i & 127; L2[d * 129 + nn] = wa[(size_t)(h * 64 + d) * 1024 + blk * 128 + nn]; }
        }
        __syncthreads();
        float acc[32];
#pragma unroll
        for (int j = 0; j < 32; ++j) acc[j] = 0.f;
#pragma unroll 2
        for (int d = 0; d < 64; ++d) {
            const float xv = L2[d * 129 + tx];
#pragma unroll
            for (int j4 = 0; j4 < 8; ++j4) { const f32x4 u = *(const LAS f32x4*)(L1 + d * 128 + rg * 32 + 4 * j4); acc[4 * j4] += xv * u[0]; acc[4 * j4 + 1] += xv * u[1]; acc[4 * j4 + 2] += xv * u[2]; acc[4 * j4 + 3] += xv * u[3]; }
        }
        if (job < 64) {
#pragma unroll
            for (int j = 0; j < 32; ++j) Win_t[(size_t)(h * 128 + rg * 32 + j) * 1024 + blk * 128 + tx] = (bf16)f2bf(acc[j] * C2);
        } else {
            unsigned char* Wuva8 = F.ws + WS_WUVA8;
#pragma unroll
            for (int j16 = 0; j16 < 2; ++j16) { v4u o;
                o.x = pg8::pk4_fp8(acc[16 * j16] * SC_WUVA, acc[16 * j16 + 1] * SC_WUVA, acc[16 * j16 + 2] * SC_WUVA, acc[16 * j16 + 3] * SC_WUVA);
                o.y = pg8::pk4_fp8(acc[16 * j16 + 4] * SC_WUVA, acc[16 * j16 + 5] * SC_WUVA, acc[16 * j16 + 6] * SC_WUVA, acc[16 * j16 + 7] * SC_WUVA);
                o.z = pg8::pk4_fp8(acc[16 * j16 + 8] * SC_WUVA, acc[16 * j16 + 9] * SC_WUVA, acc[16 * j16 + 10] * SC_WUVA, acc[16 * j16 + 11] * SC_WUVA);
                o.w = pg8::pk4_fp8(acc[16 * j16 + 12] * SC_WUVA, acc[16 * j16 + 13] * SC_WUVA, acc[16 * j16 + 14] * SC_WUVA, acc[16 * j16 + 15] * SC_WUVA);
                *(v4u*)(Wuva8 + (size_t)(blk * 128 + tx) * 1024 + h * 128 + rg * 32 + 16 * j16) = o; }
        }
        __syncthreads();
    }
    __syncthreads();
    {
        LAS float* scr = (LAS float*)(F.lds + F.wave * 16384);
        constexpr int NI_WIN = 22 * 16, NI_G8 = 128 * 16, NI_WB = 8 * 32, NI_WO = 16 * 32;
        for (int it = gw; it < NI_WIN + NI_G8 + NI_WB + NI_WO; it += NGW) {
            int r = it;
            if (r < NI_WIN) {
                const int nbk = r >> 4, kb = r & 15;
                int col0, row0, nb;
                if (nbk < 16) { col0 = 640; row0 = WR_QI; nb = nbk; }
                else if (nbk < 20) { col0 = 512; row0 = WR_T6; nb = nbk - 16; }
                else { col0 = 1152; row0 = WR_T6 + 128; nb = nbk - 20; }
                transpose_item(w_in, WIN_LD, col0, Win_t, 1024, row0, 1.f, scr, kb, nb, F.lane);
                continue;
            }
            r -= NI_WIN;
            if (r < NI_G8) { const int nb8 = r >> 4; transpose_item8(w_in, WIN_LD, nb8 < 112 ? 1224 + 32 * nb8 : 32 * (nb8 - 112), F.ws + WS_WING8, 1024, 32 * nb8, SC_WING, scr, r & 15, F.lane); continue; }
            r -= NI_G8;
            if (r < NI_WB) { transpose_item8(A.in[I_WBR], 1024, 32 * (r >> 3), F.ws + WS_WB8, 512, 32 * (r >> 3), SC_WB, scr, r & 7, F.lane); continue; }
            r -= NI_WB;
            transpose_item8(A.in[I_WOUT], 1024, 32 * (r >> 4), F.ws + WS_WOUT8, 1024, 32 * (r >> 4), SC_WOUT, scr, r & 15, F.lane);
        }
    }
    const size_t gt = (size_t)blockIdx.x * 512 + F.tid, NT = (size_t)F.G * 512;
    for (size_t i = gt; i < 65536; i += NT) { const int n = WR_T6 + 192 + (int)(i >> 10), k = (int)(i & 1023);
        const float v = (n < WR_T6 + 200) ? w_in[(size_t)k * WIN_LD + 1216 + (n - WR_T6 - 192)] : 0.f; Win_t[(size_t)n * 1024 + k] = (bf16)f2bf(v); }
    { bf16* wukt = (bf16*)(F.ws + WS_WUKT); const float* wuk = A.in[I_WUK];
      for (size_t i = gt; i < 65536; i += NT) { const int hd = (int)(i >> 13), rho = (int)(i >> 6) & 127, k = (int)(i & 63);
          const int bb = rho >> 5, rr = rho & 31, ii = ((rr >> 3) << 2) | (rr & 3), hh = (rr >> 2) & 1, delta = 16 * (2 * bb + (ii >> 3)) + 8 * hh + (ii & 7);
          wukt[i] = (bf16)f2bf(wuk[((size_t)hd * 64 + k) * 128 + delta] * C2); } }
    { float* wrt = (float*)(F.ws + WS_WRT); const float* wr = A.in[I_WR];
      for (size_t i = gt; i < 32768; i += NT) { const int e = (int)(i >> 10), k = (int)(i & 1023); wrt[i] = wr[(size_t)k * 32 + e]; } }
    { const float* x = A.in[I_X]; bf16* xb = (bf16*)(F.ws + WS_XB); unsigned char* x8 = F.ws + WS_X8;
      for (size_t i = gt; i < (size_t)NTOK * DM / 8; i += NT) { const f32x4 a = *(const f32x4*)(x + i * 8), b = *(const f32x4*)(x + i * 8 + 4);
          v4u o; o.x = pk2(a[0], a[1]); o.y = pk2(a[2], a[3]); o.z = pk2(b[0], b[1]); o.w = pk2(b[2], b[3]); *(v4u*)(xb + i * 8) = o;
          v2u q8; q8.x = pg8::pk4_fp8(a[0], a[1], a[2], a[3]); q8.y = pg8::pk4_fp8(b[0], b[1], b[2], b[3]); *(v2u*)(x8 + i * 8) = q8; } }
}

__device__ __forceinline__ void p1b_norms(Frame& F, const Args& A) {
    const float* r6 = A.out;
    bf16* ckv = (bf16*)(F.ws + WS_CKV); bf16* kidx = (bf16*)(F.ws + WS_KIDX); float* widx = (float*)(F.ws + WS_WIDX);
    const float g0 = A.in[I_KVG][2 * F.lane], g1 = A.in[I_KVG][2 * F.lane + 1];
    const float kg = A.in[I_KIG][F.lane], kb = A.in[I_KIB][F.lane];
    const int gw = F.vcu * 8 + F.wave, NGW = F.G * 8;
    for (int row0 = gw; row0 < NTOK; row0 += 4 * NGW) {
        f32x2 c[4]; float k[4], w[4];
#pragma unroll
        for (int i = 0; i < 4; ++i) { const int rl = row0 + i * NGW; const float* rp = r6 + (size_t)(rl < NTOK ? rl : NTOK - 1) * 256;
            c[i] = *(const f32x2*)(rp + 2 * F.lane); k[i] = rp[128 + F.lane]; w[i] = rp[192 + (F.lane & 7)]; }
#pragma unroll
        for (int i = 0; i < 4; ++i) { const int row = row0 + i * NGW; if (row >= NTOK) break;
            const float ms = wave_sum(c[i][0] * c[i][0] + c[i][1] * c[i][1]) * (1.f / 128.f); const float rs = 1.0f / sqrtf(ms + LN_EPS);
            *(unsigned*)(ckv + (size_t)row * 128 + 2 * F.lane) = pk2(c[i][0] * rs * g0, c[i][1] * rs * g1);
            const float mu = wave_sum(k[i]) * (1.f / 64.f); const float dk = k[i] - mu; const float var = wave_sum(dk * dk) * (1.f / 64.f);
            kidx[(size_t)row * 64 + F.lane] = (bf16)f2bf(dk * (1.0f / sqrtf(var + LN_EPS)) * kg + kb);
            if (F.lane < 8) widx[(size_t)row * 8 + F.lane] = w[i] * IDX_SCALE; }
    }
}

#define MFMA32(a, b, c) __builtin_amdgcn_mfma_f32_32x32x16_bf16((a), (b), (c), 0, 0, 0)
__device__ __forceinline__ int crow(int r, int hi) { return (r & 3) + 8 * (r >> 2) + 4 * hi; }
__device__ __forceinline__ bf16x8 pack8(const f32x16& x, int s) {
    v4u p; p.x = cvt_pk_bf16(x[8 * s], x[8 * s + 1]); p.y = cvt_pk_bf16(x[8 * s + 2], x[8 * s + 3]); p.z = cvt_pk_bf16(x[8 * s + 4], x[8 * s + 5]); p.w = cvt_pk_bf16(x[8 * s + 6], x[8 * s + 7]);
    return __builtin_bit_cast(bf16x8, p);
}
__device__ __forceinline__ float xsum32(float x) { auto r = __builtin_amdgcn_permlane32_swap(__float_as_uint(x), __float_as_uint(x), false, false); return __uint_as_float(r[0]) + __uint_as_float(r[1]); }
__device__ __forceinline__ float xsum16(float x) { auto r = __builtin_amdgcn_permlane16_swap(__float_as_uint(x), __float_as_uint(x), false, false); return __uint_as_float(r[0]) + __uint_as_float(r[1]); }
__device__ __forceinline__ float xmax32(float x) { auto r = __builtin_amdgcn_permlane32_swap(__float_as_uint(x), __float_as_uint(x), false, false); return fmaxf(__uint_as_float(r[0]), __uint_as_float(r[1])); }
__device__ __forceinline__ float xmax16(float x) { auto r = __builtin_amdgcn_permlane16_swap(__float_as_uint(x), __float_as_uint(x), false, false); return fmaxf(__uint_as_float(r[0]), __uint_as_float(r[1])); }
__device__ __forceinline__ float xmin32(float x) { auto r = __builtin_amdgcn_permlane32_swap(__float_as_uint(x), __float_as_uint(x), false, false); return fminf(__uint_as_float(r[0]), __uint_as_float(r[1])); }
__device__ __forceinline__ float xmin16(float x) { auto r = __builtin_amdgcn_permlane16_swap(__float_as_uint(x), __float_as_uint(x), false, false); return fminf(__uint_as_float(r[0]), __uint_as_float(r[1])); }
__device__ __forceinline__ unsigned xadd32u(unsigned x) { auto r = __builtin_amdgcn_permlane32_swap(x, x, false, false); return r[0] + r[1]; }
__device__ __forceinline__ unsigned xadd16u(unsigned x) { auto r = __builtin_amdgcn_permlane16_swap(x, x, false, false); return r[0] + r[1]; }
__device__ __forceinline__ unsigned xor32u(unsigned x) { auto r = __builtin_amdgcn_permlane32_swap(x, x, false, false); return r[0] | r[1]; }
constexpr int A_QI = 0;
constexpr int A_MASK = 49152;
constexpr int A_CNT = 57344;
constexpr int A_MM = 59392;
constexpr int A_BIAS = 61440;
constexpr float RESCALE_THR = 8.0f;
constexpr int A_END = 69888;
constexpr int A_LIST = 69888;
constexpr int B_WAVE_BYTES = 10752, B_HI_OFF = 73728;
constexpr int A_KV = 0;
typedef short s16x4 __attribute__((ext_vector_type(4)));
__device__ __forceinline__ s16x4 vtr(const LAS unsigned char* p) { return __builtin_bit_cast(s16x4, __builtin_amdgcn_ds_read_tr16_b64_v4i16((LAS s16x4*)p)); }

#define A_COUNT_REDUCE(cnt_local, buf, total) do { unsigned _c = xadd16u(xadd32u(cnt_local)); \
        if (lane < 16) CNT[(buf) * 256 + q16 * 8 + F.wave] = _c; __syncthreads(); \
        { const v4u _a = *(const LAS v4u*)(CNT + (buf) * 256 + q16 * 8), _b = *(const LAS v4u*)(CNT + (buf) * 256 + q16 * 8 + 4); total = (_a.x + _a.y) + (_a.z + _a.w) + (_b.x + _b.y) + (_b.z + _b.w); } } while (0)

__device__ __forceinline__ void a_unit(Frame& F, int b, int qb32) {
    const bf16* proj = (const bf16*)(F.ws + WS_PROJ);
    const bf16* ckv = (const bf16*)(F.ws + WS_CKV); const bf16* kidx = (const bf16*)(F.ws + WS_KIDX); const float* widx = (const float*)(F.ws + WS_WIDX);
    const int c = qb32 >> 1, ntile = 2 * (c + 1);
    const size_t t0 = (size_t)b * SEQ + 32 * qb32;
    int lane = F.lane, tid_ = F.tid; asm volatile("" : "+v"(lane), "+v"(tid_));
    const int q = lane & 31, hi = lane >> 5;
    LAS bf16* QI = (LAS bf16*)(F.lds + A_QI); LAS unsigned* MASK = (LAS unsigned*)(F.lds + A_MASK); LAS unsigned* CNT = (LAS unsigned*)(F.lds + A_CNT); LAS float* MM = (LAS float*)(F.lds + A_MM);
#pragma unroll
    for (int i = 0; i < 4; ++i) { const int p = tid_ + 512 * i, row = p >> 6, cc = p & 63; const v4u v = *(const v4u*)(proj + t0 * PP + C_QI + (unsigned)(row * PP + cc * 8)); *(LAS v4u*)(QI + row * 520 + cc * 8) = v; }
    __syncthreads();
    const int q16 = lane & 15, hs = (lane >> 4) & 1;
    const unsigned kl_off = (unsigned)(q * 64 + 8 * hi), ql_off = (unsigned)(q16 * 520 + hs * 64 + 8 * hi);
#ifndef REP_A13
#define REP_A13 1
#endif
#ifndef REP_A4
#define REP_A4 1
#endif
#ifndef REP_B
#define REP_B 1
#endif
    if (ntile <= 8) {
        for (int i = tid_; i < ntile * 32; i += 512) MASK[i] = 0xffffffffu;
    } else
    for (int rp13 = 0; rp13 < REP_A13; ++rp13)
    for (int qh = 0; qh < 2; ++qh) {
        float wq[4];
        { const float* wp = widx + (t0 + 16 * qh) * 8; const unsigned wo = (unsigned)(q16 * 8 + hs); wq[0] = wp[wo]; wq[1] = wp[wo + 2]; wq[2] = wp[wo + 4]; wq[3] = wp[wo + 6]; }
        f32x16 isc[4];
#ifndef REP_S1
#define REP_S1 1
#endif
#ifndef REP_S2
#define REP_S2 1
#endif
        bf16x8 qif[4][4];
#pragma unroll
        for (int p = 0; p < 4; ++p)
#pragma unroll
            for (int j = 0; j < 4; ++j) qif[p][j] = *(const LAS bf16x8*)(QI + (ql_off + 16 * qh * 520 + p * 128 + 16 * j));
        for (int rs1 = 0; rs1 < REP_S1; ++rs1)
#pragma unroll
        for (int u = 0; u < 4; ++u) {
            asm volatile("" ::: "memory");
#pragma unroll
            for (int ab = 0; ab < 2; ++ab) {
                const int T = F.wave + 8 * (2 * u + ab);
                if (T < ntile) {
                    bf16x8 kf[4];
                    const bf16* kb_ = kidx + ((size_t)b * SEQ + 32 * T) * 64;
                    unsigned ko_ = kl_off; asm volatile("" : "+v"(ko_));
#pragma unroll
                    for (int j = 0; j < 4; ++j) kf[j] = *(const bf16x8*)(kb_ + (ko_ + 16 * j));
                    f32x16 part;
#pragma unroll
                    for (int p = 0; p < 4; ++p) {
                        asm volatile("" ::: "memory"); __builtin_amdgcn_sched_barrier(0);
                        f32x16 acc;
#pragma unroll
                        for (int r = 0; r < 16; ++r) acc[r] = 0.f;
#pragma unroll
                        for (int j = 0; j < 4; ++j) acc = MFMA32(kf[j], qif[p][j], acc);
#pragma unroll
                        for (int r = 0; r < 16; ++r) part[r] = (p == 0) ? wq[0] * fmaxf(acc[r], 0.f) : fmaf(wq[p], fmaxf(acc[r], 0.f), part[r]);
                    }
#pragma unroll
                    for (int r = 0; r < 16; ++r) { const float tot = xsum16(part[r]);
                        if (ab == 0) isc[u][r] = hs ? -INFINITY : tot; else isc[u][r] = hs ? tot : isc[u][r]; }
                } else if (ab == 0) {
#pragma unroll
                    for (int r = 0; r < 16; ++r) isc[u][r] = -INFINITY;
                }
                __builtin_amdgcn_sched_barrier(0);
            }
        }
        float theta = -INFINITY, tieval = __builtin_nanf(""); int tieJ = -1;
        for (int rs2 = 0; rs2 < REP_S2; ++rs2)
        if (ntile > 8) {
            float lmin = INFINITY, lmax = -INFINITY;
#pragma unroll
            for (int u = 0; u < 4; ++u) if (F.wave + 16 * u < ntile)
#pragma unroll
                for (int r = 0; r < 16; ++r) { const float v = isc[u][r]; lmin = fminf(lmin, (v == -INFINITY) ? INFINITY : v); lmax = fmaxf(lmax, v); }
            lmin = xmin16(xmin32(lmin)); lmax = xmax16(xmax32(lmax));
            if (lane < 16) { MM[(q16 * 8 + F.wave) * 2] = lmin; MM[(q16 * 8 + F.wave) * 2 + 1] = lmax; }
            __syncthreads();
            float lo = INFINITY, hv = -INFINITY;
#pragma unroll
            for (int w = 0; w < 8; ++w) { lo = fminf(lo, MM[(q16 * 8 + w) * 2]); hv = fmaxf(hv, MM[(q16 * 8 + w) * 2 + 1]); }
            hv = fmaxf(hv, 0.f) * 1.0001f + 1e-20f;
            bool done = false, tie = false, lfin = false;
            int par = 0;
            float clo = (float)(64 * (c + 1)), chv = 0.f;
            for (int it = 0; it < 200; ++it) {
                const float half = 0.5f * (lo + hv);
                float mid = lo + (hv - lo) * ((clo - 256.5f) / (clo - chv));
                if ((it & 1) || !(mid > lo && mid < hv)) mid = half;
                if (lo < 0.f && hv > 0.f) mid = 0.f;
                else if (lo == 0.f && hv > 1.17549435e-38f) mid = 1.17549435e-38f;
                if (!done && ((lo == 0.f && hv <= 1.17549435e-38f) || mid <= lo || mid >= hv)) { done = true; tie = true; }
                if (__all(done)) break;
                unsigned cl = 0;
#pragma unroll
                for (int u = 0; u < 4; ++u) if (F.wave + 16 * u < ntile)
#pragma unroll
                    for (int r = 0; r < 16; ++r) cl += (isc[u][r] >= mid) ? 1u : 0u;
                unsigned tot; A_COUNT_REDUCE(cl, par, tot); par ^= 1;
                if (!done) { if (tot == 256u) { theta = mid; done = true; } else if (tot > 256u) { lo = mid; clo = (float)tot; } else { hv = mid; chv = (float)tot; }
                    if (!done && clo - chv <= 32.f) { done = true; lfin = true; } }
            }
            if (__any(lfin)) {
                LAS float* LIST = (LAS float*)(F.lds + A_LIST); LAS unsigned* LCNT = (LAS unsigned*)(F.lds + A_LIST + 2048);
                LAS float* QLO = (LAS float*)(F.lds + A_LIST + 2112); LAS float* QHV = QLO + 16; LAS int* QR = (LAS int*)(QHV + 16); LAS float* RESX = (LAS float*)(QR + 16); LAS int* REST = (LAS int*)(RESX + 16);
                if (F.wave == 0 && lane < 16) { LCNT[lane] = 0u; QR[lane] = lfin ? (256 - (int)chv) : 0; }
                __syncthreads();
                if (lfin) {
#pragma unroll
                    for (int u = 0; u < 4; ++u) if (F.wave + 16 * u < ntile)
#pragma unroll
                        for (int r = 0; r < 16; ++r) { const float v = isc[u][r]; if (v >= lo && v < hv) { const unsigned ix = __hip_atomic_fetch_add(LCNT + q16, 1u, __ATOMIC_RELAXED, __HIP_MEMORY_SCOPE_WORKGROUP); LIST[q16 * 32 + (ix & 31u)] = v; } }
                }
                __syncthreads();
                {
                    const int fqq = 2 * F.wave + hi, l = lane & 31; const int cnt = (int)LCNT[fqq], rr = QR[fqq];
                    const float vl = (l < cnt) ? LIST[fqq * 32 + l] : -INFINITY;
                    int gt = 0, eq = 0, before = 0;
#pragma unroll
                    for (int j = 0; j < 32; ++j) { const float vj = (j < cnt) ? LIST[fqq * 32 + j] : -INFINITY; gt += (vj > vl) ? 1 : 0; eq += (vj == vl) ? 1 : 0; before += ((vj == vl) & (j < l)) ? 1 : 0; }
                    if (rr > 0 && l < cnt && gt + before == rr - 1) { RESX[fqq] = vl; REST[fqq] = (gt + eq == rr) ? 0 : 1; }
                }
                __syncthreads();
                if (lfin) { const float x = RESX[q16];
                    if (REST[q16] == 0) theta = x;
                    else { tie = true; lo = x; hv = (x == 0.f) ? 1.17549435e-38f : __int_as_float(__float_as_int(x) + ((x > 0.f) ? 1 : -1)); } }
            }
            if (__any(tie)) {
                unsigned cl = 0;
#pragma unroll
                for (int u = 0; u < 4; ++u) if (F.wave + 16 * u < ntile)
#pragma unroll
                    for (int r = 0; r < 16; ++r) cl += (isc[u][r] >= hv) ? 1u : 0u;
                unsigned cgt; A_COUNT_REDUCE(cl, par, cgt); par ^= 1;
                const int extra = 256 - (int)cgt;
                int jlo = -1, jhi = 2047;
                for (int rd = 0; rd < 11; ++rd) {
                    const int jm = (jlo + jhi) >> 1;
                    unsigned c2 = 0;
#pragma unroll
                    for (int u = 0; u < 4; ++u) if (F.wave + 16 * u < ntile) { const int thr = jm - 32 * (F.wave + 8 * (2 * u + hs)) - 4 * hi;
#pragma unroll
                        for (int r = 0; r < 16; ++r) c2 += ((isc[u][r] == lo) & (crow(r, 0) <= thr)) ? 1u : 0u; }
                    unsigned g; A_COUNT_REDUCE(c2, par, g); par ^= 1;
                    if ((int)g >= extra) jhi = jm; else jlo = jm;
                }
                if (tie) { theta = hv; tieval = lo; tieJ = jhi; }
            }
        }
#pragma unroll
        for (int u = 0; u < 4; ++u) if (F.wave + 16 * u < ntile) { const int T = F.wave + 8 * (2 * u + hs);
            unsigned bits = 0; const int thr = tieJ - 32 * T - 4 * hi;
#pragma unroll
            for (int r = 0; r < 16; ++r) { const float v = isc[u][r]; unsigned sb = ((v >= theta) | ((v == tieval) & (crow(r, 0) <= thr))) ? 1u : 0u; asm volatile("" : "+v"(sb)); bits |= sb << crow(r, 0); }
            bits <<= 4 * hi;
            bits = xor32u(bits);
            if (hi == 0 && T < ntile) MASK[T * 32 + 16 * qh + q16] = bits; }
    }
    __syncthreads();
    for (int rp4 = 0; rp4 < REP_A4; ++rp4) {
        const int h = F.wave;
        LAS unsigned char* KV = F.lds + A_KV;
        const int drow = 4 * F.wave + (lane >> 4); const int dch = (lane & 15) ^ (((drow & 3) << 2) | ((drow >> 2) & 3));
        const bf16* sbase = ckv + (size_t)b * SEQ * 128; const unsigned dsrc = (unsigned)(drow * 128 + dch * 8);
        const unsigned kvw_ = __builtin_amdgcn_readfirstlane((unsigned)(size_t)(KV + 1024 * F.wave));
#define MLA_DMA(SS, SLOTV) do { const bf16* g_ = sbase + (size_t)(2 * (SS)) * (32 * 128) + dsrc; const bf16* g2_ = g_ + 32 * 128; \
            asm volatile("s_mov_b32 m0, %0\n\ts_nop 0\n\tglobal_load_lds_dwordx4 %1, off\n\ts_mov_b32 m0, %2\n\ts_nop 0\n\tglobal_load_lds_dwordx4 %3, off" \
                         :: "s"(kvw_ + (SLOTV)), "v"(g_), "s"(kvw_ + (SLOTV) + 8192u), "v"(g2_) : "memory", "m0"); } while (0)
        MLA_DMA(0, 0u);
        bf16x8 qf[8];
        {
            const bf16* wukt = (const bf16*)(F.ws + WS_WUKT) + h * 8192;
            bf16x8 qv[4];
#pragma unroll
            for (int ks = 0; ks < 4; ++ks) qv[ks] = *(const bf16x8*)(proj + t0 * PP + C_QLAT + h * 64 + ((unsigned)(q * PP + 8 * hi) + 16 * ks));
#pragma unroll
            for (int bb = 0; bb < 4; ++bb) {
                f32x16 cb;
#pragma unroll
                for (int r = 0; r < 16; ++r) cb[r] = 0.f;
#pragma unroll
                for (int ks = 0; ks < 4; ++ks) cb = MFMA32(*(const bf16x8*)(wukt + (unsigned)((32 * bb + q) * 64 + 16 * ks + 8 * hi)), qv[ks], cb);
                qf[2 * bb] = pack8(cb, 0); qf[2 * bb + 1] = pack8(cb, 1);
            }
        }
        f32x16 O[4];
#pragma unroll
        for (int d = 0; d < 4; ++d)
#pragma unroll
            for (int r = 0; r < 16; ++r) O[d][r] = 0.f;
        float m = NEG_BIG, l = 0.f;
        const float slope2 = __builtin_amdgcn_exp2f(-(float)(h + 1)) * LOG2E;
        const float qposf = (float)(32 * qb32 + q);
        const int Xr = ((q & 3) << 2) | ((q >> 2) & 3);
        const unsigned kbase = 256u * q + 16u * (hi ^ Xr);
        const int blk = (lane >> 4) & 1, qq = (lane & 15) >> 2, pp = lane & 3;
        unsigned vb[2];
#pragma unroll
        for (int t = 0; t < 2; ++t) vb[t] = 256u * (8 * t + 4 * hi + qq) + 64u * qq + 16u * ((2 * blk + (pp >> 1)) ^ (2 * t + hi)) + 8u * (pp & 1);
        const int nstep = ntile >> 1;
        asm volatile("s_waitcnt vmcnt(0)" ::: "memory");
        __builtin_amdgcn_s_barrier(); asm volatile("" ::: "memory");
        bf16x8 pa0, pa1, pb0, pb1;
#define MLA_PV(PSLOT) do { \
            _Pragma("unroll") for (int dt = 0; dt < 4; ++dt) { const unsigned x0 = (vb[0] ^ (64u * dt)) + (PSLOT), x1 = (vb[1] ^ (64u * dt)) + (PSLOT);        \
                const s16x4 a0 = vtr(KV + x0), a1 = vtr(KV + x1), a2 = vtr(KV + x0 + 4096), a3 = vtr(KV + x1 + 4096); \
                const s16x4 c0 = vtr(KV + x0 + 8192), c1 = vtr(KV + x1 + 8192), c2 = vtr(KV + x0 + 12288), c3 = vtr(KV + x1 + 12288); \
                const bf16x8 f0 = (bf16x8){a0[0], a0[1], a0[2], a0[3], a1[0], a1[1], a1[2], a1[3]}, f1 = (bf16x8){a2[0], a2[1], a2[2], a2[3], a3[0], a3[1], a3[2], a3[3]}; \
                const bf16x8 g0 = (bf16x8){c0[0], c0[1], c0[2], c0[3], c1[0], c1[1], c1[2], c1[3]}, g1 = (bf16x8){c2[0], c2[1], c2[2], c2[3], c3[0], c3[1], c3[2], c3[3]}; \
                O[dt] = MFMA32(f0, pa0, O[dt]); O[dt] = MFMA32(f1, pa1, O[dt]); O[dt] = MFMA32(g0, pb0, O[dt]); O[dt] = MFMA32(g1, pb1, O[dt]); } } while (0)
#define MLA_STEP(SS, SLOT, PSLOT, NSLOT, HASPV) do { \
            if ((SS) + 1 < nstep) MLA_DMA((SS) + 1, NSLOT); \
            const int T0_ = 2 * (SS); \
            f32x16 Sa, Sb; \
            _Pragma("unroll") for (int r = 0; r < 16; ++r) { Sa[r] = 0.f; Sb[r] = 0.f; } \
            {     \
                bf16x8 kf[4]; \
                _Pragma("unroll") for (int i = 0; i < 4; ++i) kf[i] = *(const LAS bf16x8*)(KV + (kbase ^ (32u * i)) + (SLOT)); \
                _Pragma("unroll") for (int i = 0; i < 16; ++i) { \
                    if (i < 8) Sa = MFMA32(kf[i & 3], qf[i & 7], Sa); else Sb = MFMA32(kf[i & 3], qf[i & 7], Sb); \
                    if (i + 4 < 16) kf[i & 3] = *(const LAS bf16x8*)(KV + (kbase ^ (32u * ((i + 4) & 7))) + (SLOT) + 8192 * ((i + 4) >> 3)); } \
                __builtin_amdgcn_sched_group_barrier(0x100, 4, 0); \
                _Pragma("unroll") for (int i = 0; i < 12; ++i) { __builtin_amdgcn_sched_group_barrier(0x008, 1, 0); __builtin_amdgcn_sched_group_barrier(0x100, 1, 0); } \
                __builtin_amdgcn_sched_group_barrier(0x008, 4, 0); \
                __builtin_amdgcn_sched_barrier(0); \
            } \
            const unsigned mwa = MASK[T0_ * 32 + q] >> (4 * hi), mwb = MASK[(T0_ + 1) * 32 + q] >> (4 * hi); \
            const float dbase = qposf - (float)(32 * T0_ + 4 * hi); \
            float tmax = -INFINITY; \
              \
            _Pragma("unroll") for (int dt = 0; dt < 4; ++dt) { \
                s16x4 a0, a1, a2, a3, c0, c1, c2, c3; \
                if (HASPV) { const unsigned x0 = (vb[0] ^ (64u * dt)) + (PSLOT), x1 = (vb[1] ^ (64u * dt)) + (PSLOT); \
                    a0 = vtr(KV + x0); a1 = vtr(KV + x1); a2 = vtr(KV + x0 + 4096); a3 = vtr(KV + x1 + 4096); \
                    c0 = vtr(KV + x0 + 8192); c1 = vtr(KV + x1 + 8192); c2 = vtr(KV + x0 + 12288); c3 = vtr(KV + x1 + 12288); \
                    __builtin_amdgcn_sched_barrier(0); } \
                _Pragma("unroll") for (int r = 4 * dt; r < 4 * dt + 4; ++r) { const int k0 = crow(r, 0); \
                    float sa_ = Sa[r] - slope2 * fabsf(dbase - (float)k0); sa_ = ((mwa >> k0) & 1u) ? sa_ : -INFINITY; Sa[r] = sa_; \
                    float sb_ = Sb[r] - slope2 * fabsf(dbase - (float)(k0 + 32)); sb_ = ((mwb >> k0) & 1u) ? sb_ : -INFINITY; Sb[r] = sb_; tmax = fmaxf(tmax, fmaxf(sa_, sb_)); } \
                if (HASPV) { __builtin_amdgcn_sched_barrier(0); \
                    const bf16x8 f0 = (bf16x8){a0[0], a0[1], a0[2], a0[3], a1[0], a1[1], a1[2], a1[3]}, f1 = (bf16x8){a2[0], a2[1], a2[2], a2[3], a3[0], a3[1], a3[2], a3[3]}; \
                    const bf16x8 g0 = (bf16x8){c0[0], c0[1], c0[2], c0[3], c1[0], c1[1], c1[2], c1[3]}, g1 = (bf16x8){c2[0], c2[1], c2[2], c2[3], c3[0], c3[1], c3[2], c3[3]}; \
                    O[dt] = MFMA32(f0, pa0, O[dt]); O[dt] = MFMA32(f1, pa1, O[dt]); O[dt] = MFMA32(g0, pb0, O[dt]); O[dt] = MFMA32(g1, pb1, O[dt]); \
                    __builtin_amdgcn_sched_barrier(0); } \
            } \
            tmax = xmax32(tmax); \
            if (__any(tmax - m > RESCALE_THR)) {        \
                const float mn = fmaxf(m, tmax); const float sc = __builtin_amdgcn_exp2f(m - mn); m = mn; l *= sc; \
                _Pragma("unroll") for (int d = 0; d < 4; ++d) _Pragma("unroll") for (int r = 0; r < 16; ++r) O[d][r] *= sc; } \
            float ps = 0.f; \
            _Pragma("unroll") for (int r = 0; r < 16; ++r) { Sa[r] = __builtin_amdgcn_exp2f(Sa[r] - m); Sb[r] = __builtin_amdgcn_exp2f(Sb[r] - m); ps += Sa[r] + Sb[r]; } \
            l += ps; \
            pa0 = pack8(Sa, 0); pa1 = pack8(Sa, 1); pb0 = pack8(Sb, 0); pb1 = pack8(Sb, 1); \
            asm volatile("s_waitcnt vmcnt(0)" ::: "memory"); \
            asm volatile("s_waitcnt lgkmcnt(0)" ::: "memory"); __builtin_amdgcn_s_barrier(); asm volatile("" ::: "memory"); \
        } while (0)
        MLA_STEP(0, 0u, 0u, 16384u, false);
        for (int ss = 1; ss < nstep; ss += 3) { MLA_STEP(ss, 16384u, 0u, 32768u, true); if (ss + 1 < nstep) MLA_STEP(ss + 1, 32768u, 16384u, 0u, true); if (ss + 2 < nstep) MLA_STEP(ss + 2, 0u, 32768u, 16384u, true); }
        { const unsigned lastslot = (unsigned)((nstep - 1) % 3) * 16384u;
          const int ln_ = lane_now(), hi_ = ln_ >> 5, blk_ = (ln_ >> 4) & 1, qq_ = (ln_ & 15) >> 2, pp_ = ln_ & 3;
#pragma unroll
          for (int t = 0; t < 2; ++t) vb[t] = 256u * (8 * t + 4 * hi_ + qq_) + 64u * qq_ + 16u * ((2 * blk_ + (pp_ >> 1)) ^ (2 * t + hi_)) + 8u * (pp_ & 1);
          MLA_PV(lastslot); }
        asm volatile("s_waitcnt lgkmcnt(0)" ::: "memory"); __builtin_amdgcn_s_barrier(); asm volatile("" ::: "memory");
#undef MLA_PV
#undef MLA_STEP
#undef MLA_DMA
        if (rp4 + 1 < REP_A4) continue;
        l = xsum32(l);
        const float inv = 1.0f / l;
        unsigned char* op = F.ws + WS_OL8 + t0 * 1024 + h * 128; const unsigned ol_off = (unsigned)(q * 1024 + 4 * hi);
#pragma unroll
        for (int dt = 0; dt < 4; ++dt)
#pragma unroll
            for (int g = 0; g < 4; ++g) *(unsigned*)(op + (ol_off + 32 * dt + 8 * g)) = pg8::pk4_fp8(O[dt][4 * g] * inv, O[dt][4 * g + 1] * inv, O[dt][4 * g + 2] * inv, O[dt][4 * g + 3] * inv);
    }
}

__device__ __forceinline__ void b_unit(Frame& F, int b, int qb32) {
    const bf16* proj = (const bf16*)(F.ws + WS_PROJ);
    const LAS float* BIAS = (const LAS float*)(F.lds + A_BIAS);
    const int c = qb32 >> 1, h = F.wave;
    const size_t t0 = (size_t)b * SEQ + 32 * qb32;
    int lane = F.lane; asm volatile("" : "+v"(lane));
    const int q = lane & 31, hi = lane >> 5;
    bf16x8 qf[4];
#pragma unroll
    for (int j = 0; j < 4; ++j) qf[j] = *(const bf16x8*)(proj + t0 * PP + C_QB + h * 64 + ((unsigned)(q * PP + 8 * hi) + 16 * j));
    LAS unsigned char* KT = F.lds + (h < 3 ? h * B_WAVE_BYTES : B_HI_OFF + (h - 3) * B_WAVE_BYTES);
    LAS unsigned char* VT = KT + 4608;
    const unsigned g_off = (unsigned)((lane >> 3) * PP + (lane & 7) * 8);
    const unsigned ks_off = (unsigned)((lane >> 3) * 144 + (lane & 7) * 16), vs_off = (unsigned)((lane >> 3) * 192 + (lane & 7) * 16);
    const unsigned kr_off = (unsigned)(q * 144 + 16 * hi);
    const int blk = (lane >> 4) & 1, qq = (lane & 15) >> 2, pp = lane & 3;
    const unsigned vr_off = (unsigned)((4 * hi + qq) * 192 + 32 * blk + 8 * pp);
    f32x16 O[2]; float m, l;
    const float cbias = BIAS[h * 264 + 256];
    for (int rpb = 0; rpb < REP_B; ++rpb) {
#pragma unroll
    for (int d = 0; d < 2; ++d)
#pragma unroll
        for (int r = 0; r < 16; ++r) O[d][r] = 0.f;
    m = NEG_BIG; l = 0.f;
    const int qpos = 32 * qb32 + q;
    const int Tlo = (c > 8) ? 2 * (c - 8) : 0, Thi = 2 * (c + 1);
    v4u kst[4], vst[4];
    { const bf16* gp = proj + ((size_t)b * SEQ + 32 * Tlo) * PP + h * 64;
#pragma unroll
      for (int i = 0; i < 4; ++i) { kst[i] = *(const v4u*)(gp + C_KB + (g_off + i * 8 * PP)); vst[i] = *(const v4u*)(gp + C_VB + (g_off + i * 8 * PP)); }
#pragma unroll
      for (int i = 0; i < 4; ++i) { *(LAS v4u*)(KT + ks_off + i * 8 * 144) = kst[i]; *(LAS v4u*)(VT + vs_off + i * 8 * 192) = vst[i]; }
      asm volatile("" ::: "memory");
      if (Tlo + 1 < Thi) { const bf16* gp2 = gp + (size_t)32 * PP;
#pragma unroll
          for (int i = 0; i < 4; ++i) { kst[i] = *(const v4u*)(gp2 + C_KB + (g_off + i * 8 * PP)); vst[i] = *(const v4u*)(gp2 + C_VB + (g_off + i * 8 * PP)); } } }
    for (int T = Tlo; T < Thi; ++T) {
        f32x16 S;
        const bool farT = (32 * qb32 - 32 * T - 31) >= 128;
        const float s_init = farT ? cbias : 0.f;
#pragma unroll
        for (int r = 0; r < 16; ++r) S[r] = s_init;
#pragma unroll
        for (int j = 0; j < 4; ++j) S = MFMA32(*(const LAS bf16x8*)(KT + kr_off + 32 * j), qf[j], S);
        s16x4 va_[2][4];
#pragma unroll
        for (int dt = 0; dt < 2; ++dt)
#pragma unroll
            for (int k4 = 0; k4 < 4; ++k4) va_[dt][k4] = vtr(VT + vr_off + 64 * dt + 8 * k4 * 192);
        __builtin_amdgcn_sched_barrier(0);
        if (T + 1 < Thi) {
            asm volatile("" ::: "memory");
#pragma unroll
            for (int i = 0; i < 4; ++i) { *(LAS v4u*)(KT + ks_off + i * 8 * 144) = kst[i]; *(LAS v4u*)(VT + vs_off + i * 8 * 192) = vst[i]; }
            asm volatile("" ::: "memory");
            if (T + 2 < Thi) { const bf16* gp = proj + ((size_t)b * SEQ + 32 * (T + 2)) * PP + h * 64;
#pragma unroll
                for (int i = 0; i < 4; ++i) { kst[i] = *(const v4u*)(gp + C_KB + (g_off + i * 8 * PP)); vst[i] = *(const v4u*)(gp + C_VB + (g_off + i * 8 * PP)); } }
            __builtin_amdgcn_sched_barrier(0);
        }
        float tmax = -INFINITY;
        if (farT) {
#pragma unroll
            for (int r = 0; r < 16; ++r) tmax = fmaxf(tmax, S[r]);
        } else {
            const int rbase = qpos - 32 * T - 4 * hi;
#pragma unroll
            for (int r = 0; r < 16; ++r) { const int rel = rbase - crow(r, 0); const int idx = (rel < 128 ? rel : 128) + 128;
                const float s = S[r] + BIAS[h * 264 + idx]; S[r] = s; tmax = fmaxf(tmax, s); }
        }
        tmax = xmax32(tmax);
        if (__any(tmax - m > RESCALE_THR)) {
            const float mn = fmaxf(m, tmax); const float sc = __builtin_amdgcn_exp2f(m - mn); m = mn; l *= sc;
#pragma unroll
            for (int d = 0; d < 2; ++d)
#pragma unroll
                for (int r = 0; r < 16; ++r) O[d][r] *= sc; }
        float ps = 0.f;
#pragma unroll
        for (int r = 0; r < 16; ++r) { S[r] = __builtin_amdgcn_exp2f(S[r] - m); ps += S[r]; }
        l += ps;
        const bf16x8 pf0 = pack8(S, 0), pf1 = pack8(S, 1);
#pragma unroll
        for (int dt = 0; dt < 2; ++dt) {
            const s16x4 a0 = va_[dt][0], a1 = va_[dt][1], a2 = va_[dt][2], a3 = va_[dt][3];
            const bf16x8 f0 = (bf16x8){a0[0], a0[1], a0[2], a0[3], a1[0], a1[1], a1[2], a1[3]}, f1 = (bf16x8){a2[0], a2[1], a2[2], a2[3], a3[0], a3[1], a3[2], a3[3]};
            O[dt] = MFMA32(f0, pf0, O[dt]); O[dt] = MFMA32(f1, pf1, O[dt]);
        }
    }
    }
    l = xsum32(l);
    const float inv = 1.0f / l;
    unsigned char* op = F.ws + WS_YB8 + t0 * 512 + h * 64; const unsigned ol_off = (unsigned)(q * 512 + 4 * hi);
    const float inv16 = inv * SC_YB;
#pragma unroll
    for (int dt = 0; dt < 2; ++dt)
#pragma unroll
        for (int g = 0; g < 4; ++g) *(unsigned*)(op + (ol_off + 32 * dt + 8 * g)) = pg8::pk4_fp8(O[dt][4 * g] * inv16, O[dt][4 * g + 1] * inv16, O[dt][4 * g + 2] * inv16, O[dt][4 * g + 3] * inv16);
}

__device__ __forceinline__ void p2_mixers(Frame& F, const Args& A) {
    LAS float* BIAS = (LAS float*)(F.lds + A_BIAS);
    for (int i = F.tid; i < 8 * 257; i += 512) { const int h = i / 257, k = i % 257; BIAS[h * 264 + k] = A.in[I_RELB][i] * LOG2E; }
    __syncthreads();
    for (int i = 0;; ++i) {
        const int L = i * F.G + F.vcu; if (L >= 2048) break;
        const int rnd = L >> 8, v = L & 255, b = v >> 3, s = v & 7;
        const int j = (rnd & 1) ? (16 * (rnd >> 1) + 15 - s) : (16 * (rnd >> 1) + s);
        a_unit(F, b, j);
        b_unit(F, b, j);
        __syncthreads();
    }
}

constexpr int P6_LOG = RING_BYTES + 1024;
constexpr int P6_HIST = P6_LOG + 8448;
__device__ __forceinline__ void p6_ln1_router(Frame& F, const Args& A) {
    const unsigned char* pre = F.ws + WS_PRE; unsigned char* x1b = F.ws + WS_X1B; unsigned char* x1q = F.ws + WS_X1Q;
    const float* wrt = (const float*)(F.ws + WS_WRT);
    int* cnt = (int*)(F.ws + WS_CNT); int* topE = (int*)(F.ws + WS_TOPE); float* topG = (float*)(F.ws + WS_TOPG);
    LAS float* WRT = (LAS float*)F.lds; LAS float* LOG = (LAS float*)(F.lds + P6_LOG); LAS int* HIST = (LAS int*)(F.lds + P6_HIST);
    for (int i = F.tid; i < 8192; i += 512) *(LAS v4u*)(WRT + 4 * i) = *(const v4u*)(wrt + 4 * i);
    if (F.tid < 32) HIST[F.tid] = 0;
    __syncthreads();
    const int lane = F.lane;
    v2u raw[4][4];
    for (int ch = blockIdx.x; ch < 256; ch += F.G) {
        for (int bt = 0; bt < 4; ++bt) {
            const int rowbase = ch * 256 + bt * 64 + F.wave * 8;
#pragma unroll 1
            for (int pr = 0; pr < 2; ++pr) {
                const int row0 = rowbase + 4 * pr;
                unsigned l4 = 4u * (unsigned)lane_now(); asm volatile("" : "+v"(l4)); const unsigned l8 = 2u * l4, l16 = 4u * l4;
#ifdef P6_LITE
                {
#else
                if (bt == 0 && pr == 0) {
#endif
#pragma unroll
                    for (int r = 0; r < 4; ++r)
#pragma unroll
                        for (int j = 0; j < 4; ++j) raw[r][j] = *(const v2u*)(pre + (size_t)(row0 + r) * 2048 + (l8 + 512u * j));
                }
                f32x4 g1[4], b1[4];
#pragma unroll
                for (int j = 0; j < 4; ++j) { g1[j] = *(const f32x4*)((const unsigned char*)A.in[I_LN1G] + (l16 + 1024u * j)); b1[j] = *(const f32x4*)((const unsigned char*)A.in[I_LN1B] + (l16 + 1024u * j)); }
                f32x4 xv[4][4];
#pragma unroll
                for (int r = 0; r < 4; ++r)
#pragma unroll
                    for (int j = 0; j < 4; ++j) xv[r][j] = (f32x4){bf_lo(raw[r][j].x), bf_hi(raw[r][j].x), bf_lo(raw[r][j].y), bf_hi(raw[r][j].y)};
#ifndef P6_LITE
                {
                    const int nrow = (pr == 0) ? row0 + 4 : ((bt < 3) ? row0 + 60 : row0);
#pragma unroll
                    for (int r = 0; r < 4; ++r)
#pragma unroll
                        for (int j = 0; j < 4; ++j) raw[r][j] = *(const v2u*)(pre + (size_t)(nrow + r) * 2048 + (l8 + 512u * j));
                }
#endif
#pragma unroll
                for (int r = 0; r < 4; ++r) {
                    float s = 0.f;
#pragma unroll
                    for (int j = 0; j < 4; ++j) s += (xv[r][j][0] + xv[r][j][1]) + (xv[r][j][2] + xv[r][j][3]);
                    const float mean = wave_sum(s) * (1.f / DM); float s2 = 0.f;
#pragma unroll
                    for (int j = 0; j < 4; ++j) { xv[r][j] = xv[r][j] - mean; s2 += (xv[r][j][0] * xv[r][j][0] + xv[r][j][1] * xv[r][j][1]) + (xv[r][j][2] * xv[r][j][2] + xv[r][j][3] * xv[r][j][3]); }
                    const float rstd = 1.f / sqrtf(wave_sum(s2) * (1.f / DM) + LN_EPS);
#pragma unroll
                    for (int j = 0; j < 4; ++j) { xv[r][j] = xv[r][j] * rstd * g1[j] + b1[j];
                        { v2u w; w.x = cvt_pk_bf16(xv[r][j][0], xv[r][j][1]); w.y = cvt_pk_bf16(xv[r][j][2], xv[r][j][3]); *(v2u*)(x1b + (size_t)(row0 + r) * 2048 + (l8 + 512u * j)) = w; }
                        *(unsigned*)(x1q + (size_t)(row0 + r) * 1024 + (l4 + 256u * j)) = pg8::pk4_fp8(xv[r][j][0], xv[r][j][1], xv[r][j][2], xv[r][j][3]); }
                }
#pragma unroll 1
                for (int g = 0; g < 4; ++g) {
                    f32x2 acc2[4][8];
#pragma unroll
                    for (int e = 0; e < 8; ++e) {
#pragma unroll
                        for (int r = 0; r < 4; ++r) acc2[r][e] = (f32x2){0.f, 0.f};
#pragma unroll
                        for (int j = 0; j < 4; ++j) { const f32x4 w = *(const LAS f32x4*)(WRT + (g * 8 + e) * 1024 + 4 * lane + 256 * j);
                            const f32x2 wl = __builtin_shufflevector(w, w, 0, 1), wh = __builtin_shufflevector(w, w, 2, 3);
#pragma unroll
                            for (int r = 0; r < 4; ++r) { acc2[r][e] = __builtin_elementwise_fma(__builtin_shufflevector(xv[r][j], xv[r][j], 0, 1), wl, acc2[r][e]); acc2[r][e] = __builtin_elementwise_fma(__builtin_shufflevector(xv[r][j], xv[r][j], 2, 3), wh, acc2[r][e]); } }
                        __builtin_amdgcn_sched_barrier(0);
                    }
#pragma unroll
                    for (int r = 0; r < 4; ++r) {
                        float t4[4], t2[2];
#pragma unroll
                        for (int e = 0; e < 4; ++e) t4[e] = swap32_sum(acc2[r][e][0] + acc2[r][e][1], acc2[r][e + 4][0] + acc2[r][e + 4][1]);
#pragma unroll
                        for (int e = 0; e < 2; ++e) t2[e] = swap16_sum(t4[e], t4[e + 2]);
                        const bool up = (lane & 8) != 0; const float keep = up ? t2[1] : t2[0], send = up ? t2[0] : t2[1];
                        float v = keep + dpp_f<0x128>(send);
                        v += dpp_f<0xB1>(v); v += dpp_f<0x4E>(v); v += dpp_f<0x141>(v);
                        if ((lane & 7) == 0) LOG[(F.wave * 8 + 4 * pr + r) * 33 + g * 8 + (lane >> 3)] = v;
                    }
                }
            }
            __syncthreads();
            if ((F.wave * 64 + lane_now()) < 64) {
                const int t = ch * 256 + bt * 64 + (F.wave * 64 + lane_now());
                float lg[32];
#pragma unroll
                for (int e = 0; e < 32; ++e) lg[e] = LOG[(F.wave * 64 + lane_now()) * 33 + e] + A.in[I_BR][e];
                int be[4]; float bv[4];
#pragma unroll
                for (int k = 0; k < 4; ++k) { float best = -INFINITY; int bi = 0;
#pragma unroll
                    for (int e = 0; e < 32; ++e) if (lg[e] > best) { best = lg[e]; bi = e; }
#pragma unroll
                    for (int e = 0; e < 32; ++e) if (e == bi) lg[e] = -INFINITY;
                    be[k] = bi; bv[k] = best; }
                float ex[4], sum = 0.f;
#pragma unroll
                for (int k = 0; k < 4; ++k) { ex[k] = __builtin_amdgcn_exp2f((bv[k] - bv[0]) * LOG2E); sum += ex[k]; }
                const float rs = 1.f / sum;
#pragma unroll
                for (int k = 0; k < 4; ++k) { topE[(size_t)t * 4 + k] = be[k]; topG[(size_t)t * 4 + k] = ex[k] * rs; __hip_atomic_fetch_add(HIST + be[k], 1, __ATOMIC_RELAXED, __HIP_MEMORY_SCOPE_WORKGROUP); }
            }
            __syncthreads();
        }
        if ((F.wave * 64 + lane_now()) < 32) { cnt[ch * 32 + (F.wave * 64 + lane_now())] = HIST[(F.wave * 64 + lane_now())]; HIST[(F.wave * 64 + lane_now())] = 0; }
        __syncthreads();
    }
}

__device__ __forceinline__ void p7_convert_dispatch(Frame& F, const Args& A) {
    {
        const int* cnt = (const int*)(F.ws + WS_CNT); const int* topE = (const int*)(F.ws + WS_TOPE); const float* topG = (const float*)(F.ws + WS_TOPG);
        int* toks = (int*)(F.ws + WS_TOKS); float* gates = (float*)(F.ws + WS_GATES); int* slots = (int*)(F.ws + WS_SLOTS); int* pstg = (int*)(F.ws + WS_PST);
        LAS int* PA = (LAS int*)F.lds;
        LAS int* PB = PA + 512;
        LAS int* TOT = PB + 512; LAS int* BEF = TOT + 32; LAS int* PSTL = BEF + 32; LAS int* BASE = PSTL + 40; LAS int* LCNT = BASE + 32;
        for (int ch = blockIdx.x; ch < 256; ch += F.G) {
            { const int e = F.tid & 31, part = F.tid >> 5; int sa = 0, sb = 0;
              for (int c2 = part * 16; c2 < part * 16 + 16; ++c2) { const int v = cnt[c2 * 32 + e]; sa += v; if (c2 < ch) sb += v; }
              PA[part * 32 + e] = sa; PB[part * 32 + e] = sb; }
            __syncthreads();
            if (F.tid < 32) { int sa = 0, sb = 0; for (int p = 0; p < 16; ++p) { sa += PA[p * 32 + F.tid]; sb += PB[p * 32 + F.tid]; } TOT[F.tid] = sa; BEF[F.tid] = sb; }
            __syncthreads();
            if (F.tid == 0) { int ps = 0; for (int e = 0; e < 32; ++e) { PSTL[e] = ps; ps += (TOT[e] + 255) & ~255; } PSTL[32] = ps; }
            __syncthreads();
            if (F.tid < 32) { BASE[F.tid] = PSTL[F.tid] + BEF[F.tid]; LCNT[F.tid] = 0; }
            __syncthreads();
            if (F.tid < 256) { const int t = ch * 256 + F.tid;
#pragma unroll
                for (int k = 0; k < 4; ++k) { const int e = topE[(size_t)t * 4 + k]; const int r = __hip_atomic_fetch_add(LCNT + e, 1, __ATOMIC_RELAXED, __HIP_MEMORY_SCOPE_WORKGROUP);
                    const int pos = BASE[e] + r; toks[pos] = t; gates[pos] = topG[(size_t)t * 4 + k]; slots[pos] = t * 4 + k; } }
            if (ch == 0) {
                for (int idx = F.tid; idx < 32 * 256; idx += 512) { const int e = idx >> 8, o = idx & 255; const int p = PSTL[e] + TOT[e] + o; if (p < PSTL[e + 1]) { toks[p] = 0; gates[p] = 0.f; slots[p] = TRASH_SLOT; } }
                if (F.tid < 33) pstg[F.tid] = PSTL[F.tid];
                { unsigned char* teg = (unsigned char*)(F.ws + WS_TE);
                  for (int idx = F.tid; idx < NTE; idx += 512) { int e = 0; for (int k = 1; k < 32; ++k) if (PSTL[k] <= idx * 256) e = k; teg[idx] = (unsigned char)e; } }
            }
            __syncthreads();
        }
    }
    __syncthreads();
    {
        LAS float* scr = (LAS float*)(F.lds + F.wave * 16384);
        const int gw = F.vcu * 8 + F.wave, NGW = F.G * 8;
        unsigned char* Wgu = F.ws + WS_WGU; unsigned char* Wd = F.ws + WS_WD;
        constexpr int PER_E = 3 * 512;
        for (int it = gw; it < NE * PER_E; it += NGW) {
            const int e = it / PER_E; int r = it % PER_E; const int which = r / 512; r %= 512;
            const int kb = r & 15, nb = r >> 4;
            if (which == 0)      transpose_item8(A.in[I_WG] + (size_t)e * DM * DFF, DFF, 32 * nb, Wgu + (size_t)e * 2048 * 1024, 1024, (nb >> 2) * 256 + (nb & 3) * 32, pg8::W8_SCALE, scr, kb, F.lane);
            else if (which == 1) transpose_item8(A.in[I_WU] + (size_t)e * DM * DFF, DFF, 32 * nb, Wgu + (size_t)e * 2048 * 1024, 1024, (nb >> 2) * 256 + 128 + (nb & 3) * 32, pg8::W8_SCALE, scr, kb, F.lane);
            else                 transpose_item8(A.in[I_WD] + (size_t)e * DFF * DM, DM, 32 * nb, Wd + (size_t)e * 1024 * 1024, 1024, 32 * nb, pg8::W8_SCALE, scr, kb, F.lane);
        }
    }
}

__device__ __forceinline__ void p16_ln2(Frame& F, const Args& A, bool poison) {
    float* xo = A.out; const unsigned char* Y = F.ws + WS_Y; const unsigned char* x1b = F.ws + WS_X1B;
    const int lane = F.lane; const int gw = F.vcu * 8 + F.wave, NGW = F.G * 8;
    f32x4 g2[4], b2[4];
#pragma unroll
    for (int j = 0; j < 4; ++j) { g2[j] = *(const f32x4*)(A.in[I_LN2G] + 4 * lane + 256 * j); b2[j] = *(const f32x4*)(A.in[I_LN2B] + 4 * lane + 256 * j); }
    const float qnan = __builtin_nanf("");
    for (int row = gw; row < NTOK; row += NGW) {
        f32x4 v[4];
#pragma unroll
        for (int j = 0; j < 4; ++j) { const v2u w = *(const v2u*)(x1b + ((size_t)row * DM + 4 * lane + 256 * j) * 2); v[j] = (f32x4){bf_lo(w.x), bf_hi(w.x), bf_lo(w.y), bf_hi(w.y)} * DN_ALPHA; }
#pragma unroll
        for (int k = 0; k < 4; ++k)
#pragma unroll
            for (int j = 0; j < 4; ++j) { const unsigned w = *(const unsigned*)(Y + ((size_t)row * 4 + k) * DM + 4 * lane + 256 * j);
                const f32x2 lo = __builtin_amdgcn_cvt_pk_f32_fp8(w, false), hi2 = __builtin_amdgcn_cvt_pk_f32_fp8(w, true);
                v[j][0] += lo[0] * (1.0f / SC_Y); v[j][1] += lo[1] * (1.0f / SC_Y); v[j][2] += hi2[0] * (1.0f / SC_Y); v[j][3] += hi2[1] * (1.0f / SC_Y); }
        float s = 0.f;
#pragma unroll
        for (int j = 0; j < 4; ++j) s += (v[j][0] + v[j][1]) + (v[j][2] + v[j][3]);
        const float mean = wave_sum(s) * (1.f / DM); float s2 = 0.f;
#pragma unroll
        for (int j = 0; j < 4; ++j) { v[j] = v[j] - mean; s2 += (v[j][0] * v[j][0] + v[j][1] * v[j][1]) + (v[j][2] * v[j][2] + v[j][3] * v[j][3]); }
        const float rstd = 1.f / sqrtf(wave_sum(s2) * (1.f / DM) + LN_EPS);
#pragma unroll
        for (int j = 0; j < 4; ++j) { f32x4 o = v[j] * rstd * g2[j] + b2[j]; if (poison) o = (f32x4){qnan, qnan, qnan, qnan}; *(f32x4*)(xo + (size_t)row * DM + 4 * lane + 256 * j) = o; }
    }
}

constexpr int NPHASE = 11;
#ifndef MOE_ALIGN
#define MOE_ALIGN true
#endif
__global__ void __launch_bounds__(512, 2) mk_fwd(Args args) {
    extern __shared__ __attribute__((aligned(16))) unsigned char lds[];
    Frame F;
    F.lds = (LAS unsigned char*)lds;
    F.wave = __builtin_amdgcn_readfirstlane((int)threadIdx.x >> 6); F.lane = lane_now(); F.tid = F.wave * 64 + F.lane;
#define REFRESH() do { F.lane = lane_now(); F.tid = F.wave * 64 + F.lane; } while (0)
    F.G = gridDim.x; { const int bx = blockIdx.x; F.vcu = (F.G % 8 == 0) ? (bx % 8) * (F.G / 8) + bx / 8 : bx; }
    F.ws = args.ws; F.ctl = (unsigned*)(args.ws + WS_CTL);
    for (int u = F.tid; u < 64; u += 512) ((LAS unsigned*)(F.lds + MISC_OFF))[u] = 0u;
    __syncthreads();
    volatile LAS unsigned* MISC = (volatile LAS unsigned*)(F.lds + MISC_OFF);
    XcdBarrier bar = xcd_barrier_post(F.ctl + CW_BAR + args.li * XCD_BAR_WORDS, MISC + 8);
    const int lo = args.ph_lo, hi = args.ph_hi;
#define IN(k) (lo <= (k) && (k) < hi)
#define SEAM(k) do { if (IN(k) && IN((k) + 1)) xcd_barrier(bar); } while (0)
    unsigned char* ws = args.ws;
    const pg8::bf16_t* proj = (const pg8::bf16_t*)(ws + WS_PROJ);

#ifndef REP_P0
#define REP_P0 1
#endif
#ifndef REP_A
#define REP_A 1
#endif
#ifndef REP_P1
#define REP_P1 1
#endif
#ifndef REP_34
#define REP_34 1
#endif
#ifndef REP_56
#define REP_56 1
#endif
#ifndef REP_5
#define REP_5 1
#endif
#ifndef REP_7
#define REP_7 1
#endif
#ifndef REP_MOE
#define REP_MOE 1
#endif
    for (int r0 = 0; r0 < REP_P0; ++r0) {
        if (IN(0)) { REFRESH(); p0_prologue(F, args); }
        SEAM(0);
    }
    for (int ra = 0; ra < REP_A; ++ra) {
        for (int r1 = 0; r1 < REP_P1; ++r1) {
            if (IN(1)) {
                { pg8::SchedDense S{256, 3, F.G, (int)blockIdx.x, (const char*)(ws + WS_XB), (size_t)256 * 1024 * 2, (const char*)(ws + WS_WIN), (size_t)256 * 1024 * 2};
                  pg8::EpiProj E{(pg8::bf16_t*)(ws + WS_PROJ), args.out};
                  pg8::gemm_phase<pg8::EpiProj, pg8::SchedDense, false>(F.lds, F.wave, 2048, 2048, S, E); }
                { pg8::SchedDense S{256, 16, F.G, (int)blockIdx.x, (const char*)(ws + WS_X8), (size_t)256 * 1024, (const char*)(ws + WS_WING8), (size_t)256 * 1024};
                  pg8::EpiGate8 E{(pg8::bf16_t*)(ws + WS_PROJ)};
                  pg8::gemm_phase<pg8::EpiGate8, pg8::SchedDense, false, true>(F.lds, F.wave, 1024, 1024, S, E); }
            }
            SEAM(1);
        }
        if (IN(2)) { REFRESH(); p1b_norms(F, args); }
        SEAM(2);
        if (IN(3)) { REFRESH(); p2_mixers(F, args); }
        SEAM(3);
    }
    for (int rb = 0; rb < REP_34; ++rb) {
        if (IN(4)) {
            { pg8::SchedDense S{256, 4, F.G, (int)blockIdx.x, (const char*)(ws + WS_OL8), (size_t)256 * 1024, (const char*)(ws + WS_WUVA8), (size_t)256 * 1024};
              pg8::EpiMerge<false> E{(const unsigned char*)proj + pg8::GATE8_OFF, (pg8::bf16_t*)(proj + C_GB), nullptr};
              pg8::gemm_phase<pg8::EpiMerge<false>, pg8::SchedDense, false, true>(F.lds, F.wave, 1024, 1024, S, E); }
            { pg8::SchedDense S{256, 4, F.G, (int)blockIdx.x, (const char*)(ws + WS_YB8), (size_t)256 * 512, (const char*)(ws + WS_WB8), (size_t)256 * 512};
              pg8::EpiMerge<true> E{(const unsigned char*)proj + pg8::GATE8_OFF + 1024, (pg8::bf16_t*)(proj + C_GB), ws + WS_X8};
              pg8::gemm_phase<pg8::EpiMerge<true>, pg8::SchedDense, false, true>(F.lds, F.wave, 512, 512, S, E); }
        }
        SEAM(4);
    }
    for (int rc = 0; rc < REP_56; ++rc) {
        for (int r5 = 0; r5 < REP_5; ++r5) {
            if (IN(5)) {
                pg8::SchedDense S{256, 4, F.G, (int)blockIdx.x, (const char*)(ws + WS_X8), (size_t)256 * 1024, (const char*)(ws + WS_WOUT8), (size_t)256 * 1024};
                pg8::EpiOut E{(const pg8::bf16_t*)(ws + WS_XB), (pg8::bf16_t*)(ws + WS_PRE)};
                pg8::gemm_phase<pg8::EpiOut, pg8::SchedDense, false, true>(F.lds, F.wave, 1024, 1024, S, E);
            }
            SEAM(5);
        }
        if (IN(6)) { REFRESH(); p6_ln1_router(F, args); }
        SEAM(6);
    }
    for (int r7 = 0; r7 < REP_7; ++r7) {
        if (IN(7)) { REFRESH(); p7_convert_dispatch(F, args); }
        SEAM(7);
    }
    for (int r8 = 0; r8 < REP_MOE; ++r8) {
    if (hi > 8 && lo < 10) {
        REFRESH();
        const unsigned char* teg = (const unsigned char*)(ws + WS_TE);
        for (int i = F.tid; i < NTE; i += 512) F.lds[TE_LDS + i] = teg[i];
        __syncthreads();
    }
    int total_tiles = __builtin_amdgcn_readfirstlane((int)__hip_atomic_load((const unsigned*)(ws + WS_PST) + 32, RLX_AGENT)) >> 8;
    if (total_tiles > HCAP_TILES) { total_tiles = HCAP_TILES; if (F.wave == 0 && lane_now() == 0) __hip_atomic_store(F.ctl + CW_ERR, 1u, RLX_AGENT); }
#ifndef REP_GU
#define REP_GU 1
#endif
#ifndef REP_DN
#define REP_DN 1
#endif
    for (int rgu = 0; rgu < REP_GU; ++rgu) {
    if (IN(8)) {
        pg8::SchedMoe<8, true> S; S.nM = total_tiles; S.tile0 = 0; S.te = (const PG8_LAS unsigned char*)(F.lds + TE_LDS);
        S.A = (const char*)(ws + WS_X1Q); S.B = (const char*)(ws + WS_WGU); S.toks = (const int*)(ws + WS_TOKS);
        pg8::EpiGU E{args.in[I_BG], args.in[I_BU], ws + WS_H};
        pg8::gemm_phase<pg8::EpiGU, pg8::SchedMoe<8, true>, true, true, MOE_ALIGN>(F.lds, F.wave, 1024, 1024, S, E);
    }
    SEAM(8);
    }
    for (int rdn = 0; rdn < REP_DN; ++rdn) {
    if (IN(9)) {
        pg8::SchedMoe<4, false> S; S.nM = total_tiles; S.tile0 = 0; S.te = (const PG8_LAS unsigned char*)(F.lds + TE_LDS);
        S.A = (const char*)(ws + WS_H); S.B = (const char*)(ws + WS_WD); S.toks = (const int*)(ws + WS_TOKS);
        pg8::EpiDown E{args.in[I_BD], (const float*)(ws + WS_GATES), (const int*)(ws + WS_SLOTS), ws + WS_Y};
        pg8::gemm_phase<pg8::EpiDown, pg8::SchedMoe<4, false>, false, true, MOE_ALIGN>(F.lds, F.wave, 1024, 1024, S, E);
    }
    SEAM(9);
    }
    }
    if (IN(10)) {
        REFRESH();
        bool poison = (__hip_atomic_load(F.ctl + CW_TMO, RLX_AGENT) != 0u) || (__hip_atomic_load(F.ctl + CW_ERR, RLX_AGENT) != 0u);
        for (int li = 0; li < NPHASE; ++li) poison |= __hip_atomic_load(F.ctl + CW_BAR + li * XCD_BAR_WORDS + XB_TMO, RLX_AGENT) != 0u;
        REFRESH(); p16_ln2(F, args, poison);
    }
#undef IN
#undef SEAM
}

extern "C" void kernel_launch(void* const* d_in, const int* in_sizes, int n_in, void* d_out, int out_size, void* d_ws, size_t ws_size, hipStream_t stream) {
    static int grid = 0;
    if (grid == 0) {
        if (n_in != 23 || in_sizes[0] != NTOK * DM || out_size != NTOK * DM || ws_size < WS_END) { fprintf(stderr, "kernel_launch: unexpected shapes (n_in %d, in0 %d, out %d, ws %zu)\n", n_in, n_in > 0 ? in_sizes[0] : -1, out_size, ws_size); grid = -1; return; }
        int dev = 0, cus = 0;
        if (hipGetDevice(&dev) != hipSuccess || hipDeviceGetAttribute(&cus, hipDeviceAttributeMultiprocessorCount, dev) != hipSuccess) { grid = -1; return; }
        if (hipFuncSetAttribute((const void*)mk_fwd, hipFuncAttributeMaxDynamicSharedMemorySize, LDS_BYTES) != hipSuccess) { fprintf(stderr, "kernel_launch: hipFuncSetAttribute failed\n"); grid = -1; return; }
        int per_cu = 0;
        if (hipOccupancyMaxActiveBlocksPerMultiprocessor(&per_cu, (const void*)mk_fwd, 512, LDS_BYTES) != hipSuccess || per_cu < 1) fprintf(stderr, "kernel_launch: occupancy query reports %d\n", per_cu);
        (void)hipGetLastError();
        grid = cus;
    }
    if (grid < 0) return;
    if (hipMemsetAsync((char*)d_ws + WS_CTL, 0, CTL_ZERO_BYTES, stream) != hipSuccess) return;
    Args a{};
    for (int i = 0; i < 23; ++i) a.in[i] = (const float*)d_in[i];
    a.out = (float*)d_out; a.ws = (unsigned char*)d_ws;
#if MK_ONE_LAUNCH
    a.ph_lo = 0; a.ph_hi = NPHASE; a.li = 0; a.pad = 0;
    hipLaunchKernelGGL(mk_fwd, dim3(grid), dim3(512), LDS_BYTES, stream, a);
#else
    for (int ph = 0; ph < NPHASE; ++ph) { a.ph_lo = ph; a.ph_hi = ph + 1; a.li = ph; a.pad = 0; hipLaunchKernelGGL(mk_fwd, dim3(grid), dim3(512), LDS_BYTES, stream, a); }
#endif
}
```

```cpp
#include <hip/hip_runtime.h>
#pragma clang fp reassociate(on) contract(fast)
#include <cstdio>
#include <cstdint>

#ifndef MK_ONE_LAUNCH
#define MK_ONE_LAUNCH 1
#endif

#define GAS __attribute__((address_space(1)))
#define LAS __attribute__((address_space(3)))
typedef unsigned short bf16;
typedef unsigned v4u __attribute__((ext_vector_type(4)));
typedef unsigned v2u __attribute__((ext_vector_type(2)));
typedef float f32x4 __attribute__((ext_vector_type(4)));
typedef float f32x2 __attribute__((ext_vector_type(2)));
typedef float f32x16 __attribute__((ext_vector_type(16)));
typedef short bf16x8 __attribute__((ext_vector_type(8)));
#define RLX_AGENT __ATOMIC_RELAXED, __HIP_MEMORY_SCOPE_AGENT
#define LDS_WAIT() asm volatile("s_waitcnt lgkmcnt(0)" ::: "memory")
#define VM_WAIT() asm volatile("s_waitcnt vmcnt(0)" ::: "memory")

constexpr int NTOK = 65536, DM = 1024, NB = 32, SEQ = 2048;
constexpr int NE = 32, DFF = 1024;
constexpr int WIN_LD = 4808;
constexpr int PP = 5376;
constexpr int C_QLAT = 0, C_QI = 1024, C_T6 = 1536, C_QB = 1792, C_KB = 2304, C_VB = 2816, C_GA = 3328, C_GB = 4352;
constexpr int WR_QI = 0, WR_T6 = 512;
constexpr float LOG2E = 1.4426950408889634f;
constexpr float C2 = 0.125f * LOG2E;
constexpr float IDX_SCALE = 0.044194173824159216f;
constexpr float DN_ALPHA = 1.189207115002721f;
constexpr float LN_EPS = 1e-5f;
constexpr float NEG_BIG = -1e30f;

constexpr size_t MiB = 1u << 20;
constexpr size_t WS_CTL = 0, CTL_ZERO_BYTES = 1 * MiB;
constexpr size_t WS_WIN = 1 * MiB, WS_WUVA = 12 * MiB, WS_WB = 14 * MiB, WS_WOUT = 15 * MiB;
constexpr size_t WS_CKV = 17 * MiB, WS_CKVT = 33 * MiB, WS_KIDX = 49 * MiB, WS_WIDX = 57 * MiB, WS_VBT = 59 * MiB;
constexpr size_t WS_WING8 = 38 * MiB;
constexpr size_t WS_WUVA8 = 35 * MiB;
constexpr size_t WS_WB8 = 36 * MiB;
constexpr size_t WS_WOUT8 = 37 * MiB;
constexpr size_t WS_X8 = 59 * MiB;
constexpr size_t WS_OL8 = 928 * MiB;
constexpr size_t WS_YB8 = 992 * MiB;
constexpr float SC_WING = 32.f, SC_WUVA = 64.f, SC_WB = 32.f, SC_WOUT = 64.f, SC_YB = 16.f, SC_M = 8.f;
constexpr size_t WS_WUKT = 8 * MiB;
constexpr size_t WS_WRT = 11 * MiB + 512 * 1024;
constexpr size_t WS_PROJ = 128 * MiB;
constexpr size_t WS_XB = 800 * MiB;
constexpr size_t WS_PRE = 256 * MiB;
constexpr size_t WS_X1B = 768 * MiB;
constexpr size_t WS_CNT = 1 * MiB;
constexpr size_t WS_PST = 1 * MiB + 64 * 1024;
constexpr size_t WS_TE = 1 * MiB + 96 * 1024;
constexpr int NTE = 1088;
constexpr size_t WS_TOPE = 2 * MiB, WS_TOPG = 3 * MiB;
constexpr size_t WS_TOKS = 4 * MiB, WS_GATES = 6 * MiB, WS_SLOTS = 8 * MiB;
constexpr size_t WS_WGU = 16 * MiB;
constexpr size_t WS_WD = 80 * MiB;
constexpr size_t WS_X1Q = 112 * MiB;
constexpr size_t WS_H = 176 * MiB;
constexpr size_t WS_Y = 512 * MiB;
constexpr size_t WS_END = 1024 * MiB;
constexpr int HCAP_TILES = 1088;
constexpr int MAXROWS = (1024 + 32) * 256;
constexpr size_t WS_TRASH = 12 * MiB;
constexpr int TRASH_SLOT = -(int)((WS_Y - WS_TRASH) / 1024);
constexpr float SC_Y = 16.f;
constexpr int CW_TMO = 0, CW_ERR = 2;
constexpr int CW_BAR = 4096;

constexpr int RING_BYTES = 131072;
constexpr int LDS_BYTES = 147456;
constexpr int MISC_OFF = LDS_BYTES - 256;
constexpr int NV_LDS = RING_BYTES + 4096;
constexpr int EPG_LDS = RING_BYTES + 12288;
constexpr int TE_LDS = RING_BYTES + 1024;

__device__ __forceinline__ unsigned f2bf(float f) { unsigned u = __builtin_bit_cast(unsigned, f); return (u + 0x7fffu + ((u >> 16) & 1u)) >> 16; }
__device__ __forceinline__ unsigned pk2(float lo, float hi) { return f2bf(lo) | (f2bf(hi) << 16); }
typedef __bf16 bf16x2_t_ __attribute__((ext_vector_type(2)));
__device__ __forceinline__ unsigned cvt_pk_bf16(float lo, float hi) { f32x2 v = {lo, hi}; bf16x2_t_ b = __builtin_convertvector(v, bf16x2_t_); return __builtin_bit_cast(unsigned, b); }
__device__ __forceinline__ float bf_lo(unsigned w) { return __uint_as_float(w << 16); }
__device__ __forceinline__ float bf_hi(unsigned w) { return __uint_as_float(w & 0xffff0000u); }
__device__ __forceinline__ float sigmoidf_(float x) { return __builtin_amdgcn_rcpf(1.0f + __builtin_amdgcn_exp2f(-LOG2E * x)); }
template <int CTRL> __device__ __forceinline__ float dpp_f(float x) { return __builtin_bit_cast(float, __builtin_amdgcn_update_dpp(0, __builtin_bit_cast(int, x), CTRL, 0xF, 0xF, true)); }
__device__ __forceinline__ float swap16_sum(float d, float s_) { auto r = __builtin_amdgcn_permlane16_swap(__float_as_uint(d), __float_as_uint(s_), false, false); return __uint_as_float(r[0]) + __uint_as_float(r[1]); }
__device__ __forceinline__ float swap32_sum(float d, float s_) { auto r = __builtin_amdgcn_permlane32_swap(__float_as_uint(d), __float_as_uint(s_), false, false); return __uint_as_float(r[0]) + __uint_as_float(r[1]); }
__device__ __forceinline__ float wave_sum(float v) {
    v += dpp_f<0xB1>(v);
    v += dpp_f<0x4E>(v);
    v += dpp_f<0x141>(v);
    v += dpp_f<0x140>(v);
    v = swap16_sum(v, v);
    return swap32_sum(v, v);
}

__device__ __forceinline__ int lane_now() { int l; asm volatile("v_mbcnt_lo_u32_b32 %0, -1, 0\n\tv_mbcnt_hi_u32_b32 %0, -1, %0" : "=v"(l)); return l; }
namespace pg8 {
#define PG8_LAS __attribute__((address_space(3)))
typedef unsigned short bf16_t;
constexpr int BM = 256, BK = 64, HALF = 128, HTB = HALF * BK * 2, STAGE_BYTES = 8 * HTB, NXCD = 8, WGM = 8;
__host__ __device__ __forceinline__ int lds_byte(int r, int c) { const int st = (r >> 4) * 2 + (c >> 5), rr = r & 15, cc = c & 31, ob = rr * 64 + cc * 2; return st * 1024 + (ob ^ (((ob >> 9) & 1) << 5)); }
__host__ __device__ __forceinline__ void stage_rc(int b, int& R, int& C) { const int st = b / 1024, sb = b % 1024, swz = sb ^ (((sb >> 9) & 1) << 5); R = (st >> 1) * 16 + swz / 64; C = (st & 1) * 32 + (swz % 64) / 2; }
__host__ __device__ __forceinline__ int perm32(int rho) { const int n = rho >> 4, i = rho & 15; return 8 * (i >> 2) + 4 * n + (i & 3); }

struct Unit { int pm, pn, e, gt; const char* a; const char* b; const int* rows; };

__device__ __forceinline__ bool static_pmpn(int i, int G, int c, int nM, int nN, int& pm, int& pn) {
    i = __builtin_amdgcn_readfirstlane(i); const int nwg = nM * nN; const long L = (long)i * G + c; if (L >= nwg) return false;
    int wgid = (int)L; { const int q = nwg / NXCD, r = nwg % NXCD, xcd = wgid % NXCD, off = wgid / NXCD; wgid = (xcd < r ? xcd * (q + 1) : r * (q + 1) + (xcd - r) * q) + off; }
    const int nig = WGM * nN, gid = wgid / nig, fm = gid * WGM, gsz = (nM - fm) < WGM ? (nM - fm) : WGM;
    pm = __builtin_amdgcn_readfirstlane(fm + ((wgid % nig) % gsz)); pn = __builtin_amdgcn_readfirstlane((wgid % nig) / gsz); return true;
}
struct SchedDense {
    int nM, nN, G, c; const char* A; size_t a_t; const char* B; size_t b_t;
    __device__ __forceinline__ bool next(int i, Unit& u) const {
        int pm, pn; if (!static_pmpn(i, G, c, nM, nN, pm, pn)) return false;
        u.pm = pm; u.pn = pn; u.e = 0; u.gt = pm; u.a = A + (size_t)pm * a_t; u.b = B + (size_t)pn * b_t; u.rows = nullptr; return true;
    }
};
template <int NN, bool GATHERA> struct SchedMoe {
    int nM, tile0; const PG8_LAS unsigned char* te; const char* A; const char* B; const int* toks;
    static constexpr size_t B_E = (size_t)NN * 256 * 1024, B_T = (size_t)256 * 1024, A_T = (size_t)256 * 1024;
    __device__ __forceinline__ bool next(int i, Unit& u) const {
        int pm, pn; if (!static_pmpn(i, (int)gridDim.x, (int)blockIdx.x, nM, NN, pm, pn)) return false;
        const int gt = tile0 + pm; const int e = __builtin_amdgcn_readfirstlane((int)te[gt]);
        u.pm = pm; u.pn = pn; u.e = e; u.gt = gt; u.a = GATHERA ? A : A + (size_t)pm * A_T; u.b = B + (size_t)e * B_E + (size_t)pn * B_T; u.rows = toks + (size_t)gt * 256; return true;
    }
};

typedef int i32x8 __attribute__((ext_vector_type(8)));
constexpr float W8_SCALE = 64.0f, W8_INV = 1.0f / 64.0f;
__device__ __forceinline__ i32x8 cat8(const bf16x8& a, const bf16x8& b) { const v4u x = __builtin_bit_cast(v4u, a), y = __builtin_bit_cast(v4u, b); return (i32x8){(int)x.x, (int)x.y, (int)x.z, (int)x.w, (int)y.x, (int)y.y, (int)y.z, (int)y.w}; }
template <class Epi, class Sched, bool GATHER, bool FP8 = false, bool ALIGN_EPI = true>
__device__ __forceinline__ void gemm_phase(PG8_LAS unsigned char* lds, const int wid, const int Kb, const int ldab, const Sched& S, const Epi& E) {
    const int lane = lane_now(), tid = wid * 64 + lane, wr = wid >> 2, wc = wid & 3;
    const int nt = Kb / 128;
    const size_t kstep = (size_t)128;
    const size_t hstepB = (size_t)HALF * Kb;
    const unsigned ldsw = (unsigned)wid * 1024u;
    const unsigned ldsb_ = __builtin_amdgcn_readfirstlane((unsigned)(size_t)lds);
#define PG8_LANE_OFFS() const int _ln = lane_now(); \
    const int aoff = lds_byte(wr * 64 + (_ln & 15), (_ln >> 4) * 8), boff = lds_byte(wc * 32 + (_ln & 15), (_ln >> 4) * 8); \
    unsigned voffB0; { int _R, _C; stage_rc((wid * 64 + _ln) * 16, _R, _C); const int _Rb = Epi::PERM ? ((_R & ~31) + perm32(_R & 31)) : _R; voffB0 = (unsigned)(_Rb * Kb + _C * 2); } \
    const unsigned voffB1 = voffB0 + 64u * (unsigned)Kb;
#define PG8_SA(b, h) (((b) * 2 + (h)) * HTB)
#define PG8_SB(b, h) ((4 + (b) * 2 + (h)) * HTB)
#define PG8_STAGE2(bufoff, gbase, v0, v1) do { const unsigned m0a_ = ldsb_ + (unsigned)(bufoff) + ldsw; const char* gb_ = (const char*)(gbase); \
        asm volatile("s_mov_b32 m0, %0\n\ts_nop 0\n\tglobal_load_lds_dwordx4 %1, %2\n\ts_mov_b32 m0, %3\n\ts_nop 0\n\tglobal_load_lds_dwordx4 %4, %2" \
                     :: "s"(m0a_), "v"(v0), "s"(gb_), "s"(m0a_ + 8192u), "v"(v1) : "memory", "m0"); } while (0)
#define PG8_STAGEB(bufoff, gbase) PG8_STAGE2(bufoff, gbase, voffB0, voffB1)
#define PG8_MKA(u, v) do { const int _tid = wid * 64 + lane_now(); _Pragma("unroll") for (int _i = 0; _i < 2; ++_i) { int _R, _C; stage_rc(_tid * 16 + _i * 8192, _R, _C); _Pragma("unroll") for (int _h = 0; _h < 2; ++_h) { \
        const int _row = _h * HALF + _R; const int _t = GATHER ? (u).rows[_row] : _row; v[_h][_i] = (unsigned)(_t * ldab + _C * 2); } } } while (0)
#define PG8_LDA(dst, b, h) do { _Pragma("unroll") for (int m = 0; m < 4; ++m) { const v4u _x = *(const PG8_LAS v4u*)(lds + PG8_SA(b, h) + aoff + m * 2048), _y = *(const PG8_LAS v4u*)(lds + PG8_SA(b, h) + aoff + m * 2048 + 1024); \
        dst[m] = (i32x8){(int)_x.x, (int)_x.y, (int)_x.z, (int)_x.w, (int)_y.x, (int)_y.y, (int)_y.z, (int)_y.w}; } } while (0)
#define PG8_LDB(dst, b, h) do { _Pragma("unroll") for (int n = 0; n < 2; ++n) { const v4u _x = *(const PG8_LAS v4u*)(lds + PG8_SB(b, h) + boff + n * 2048), _y = *(const PG8_LAS v4u*)(lds + PG8_SB(b, h) + boff + n * 2048 + 1024); \
        dst[n] = (i32x8){(int)_x.x, (int)_x.y, (int)_x.z, (int)_x.w, (int)_y.x, (int)_y.y, (int)_y.z, (int)_y.w}; } } while (0)
#define PG8_LO(v) __builtin_bit_cast(bf16x8, (v4u){(unsigned)(v)[0], (unsigned)(v)[1], (unsigned)(v)[2], (unsigned)(v)[3]})
#define PG8_HI(v) __builtin_bit_cast(bf16x8, (v4u){(unsigned)(v)[4], (unsigned)(v)[5], (unsigned)(v)[6], (unsigned)(v)[7]})
#define PG8_MMA(ai, bj, At, Bt) do { __builtin_amdgcn_s_setprio(1); \
        if constexpr (FP8) { _Pragma("unroll") for (int m = 0; m < 4; ++m) _Pragma("unroll") for (int n = 0; n < 2; ++n) \
            asm volatile("v_mfma_f32_16x16x128_f8f6f4 %0, %1, %2, %0" : "+v"(acc[ai][bj][m][n]) : "v"(Bt[n]), "v"(At[m])); } \
        else { _Pragma("unroll") for (int m = 0; m < 4; ++m) _Pragma("unroll") for (int n = 0; n < 2; ++n) { \
            acc[ai][bj][m][n] = __builtin_amdgcn_mfma_f32_16x16x32_bf16(PG8_LO(Bt[n]), PG8_LO(At[m]), acc[ai][bj][m][n], 0, 0, 0); \
            acc[ai][bj][m][n] = __builtin_amdgcn_mfma_f32_16x16x32_bf16(PG8_HI(Bt[n]), PG8_HI(At[m]), acc[ai][bj][m][n], 0, 0, 0); } } \
        __builtin_amdgcn_s_setprio(0); } while (0)
#define PG8_WAIT_V(n) asm volatile("s_waitcnt vmcnt(" #n ")" ::: "memory")
#define PG8_WAIT_L(n) asm volatile("s_waitcnt lgkmcnt(" #n ")" ::: "memory")
#define PG8_BAR __builtin_amdgcn_s_barrier()
#define PG8_SCHED __builtin_amdgcn_sched_barrier(0)
    Unit cur, nxt; int ui = 0;
    if (!S.next(0, cur)) return;
    f32x4 acc[2][2][4][2];
#pragma unroll
    for (int a = 0; a < 2; ++a)
#pragma unroll
        for (int b = 0; b < 2; ++b)
#pragma unroll
            for (int m = 0; m < 4; ++m)
#pragma unroll
                for (int n = 0; n < 2; ++n) acc[a][b][m][n] = (f32x4){0.f, 0.f, 0.f, 0.f};
    i32x8 At[4], B0[2], B1[2];
    unsigned vA[2][2];
    PG8_MKA(cur, vA);
    const char* cA = cur.a; const char* cB = cur.b;
    PG8_LANE_OFFS();
    {
    PG8_STAGEB(PG8_SB(0, 0), cB); PG8_STAGEB(PG8_SB(0, 1), cB + hstepB); PG8_STAGE2(PG8_SA(0, 0), cA, vA[0][0], vA[0][1]); PG8_STAGE2(PG8_SA(0, 1), cA, vA[1][0], vA[1][1]);
    if (wr == 1) PG8_BAR;
    PG8_WAIT_V(2); PG8_BAR;
    PG8_STAGEB(PG8_SB(1, 0), cB + kstep); PG8_STAGE2(PG8_SA(1, 0), cA + kstep, vA[0][0], vA[0][1]); PG8_STAGEB(PG8_SB(1, 1), cB + hstepB + kstep);
    PG8_WAIT_V(6); PG8_BAR; }
    for (;;) {
        const bool has_next = S.next(ui + 1, nxt);
        if constexpr (Epi::HAS_PF) E.prefetch(lds, cur, wid, ui & 1);
        if (GATHER) { if (has_next) {
            __builtin_amdgcn_global_load_lds((const unsigned*)(nxt.rows + 4 * lane_now()), (PG8_LAS unsigned*)(lds + NV_LDS + wid * 1024), 16, 0, 0); } }
        const char* nA = has_next ? nxt.a : cA; const char* nB = has_next ? nxt.b : cB;
#pragma clang loop unroll(disable)
        for (int t = 0; t < nt; t += 2) {
            const bool last = (t == nt - 2);
            const char* a1 = cA + (size_t)(t + 1) * kstep;
            const char* a2 = last ? nA : cA + (size_t)(t + 2) * kstep; const char* b2 = last ? nB : cB + (size_t)(t + 2) * kstep;
            const char* a3 = a2 + kstep; const char* b3 = b2 + kstep;
            PG8_LDB(B0, 0, 0); PG8_LDB(B1, 0, 1); PG8_SCHED; PG8_LDA(At, 0, 0); PG8_STAGE2(PG8_SA(1, 1), a1, vA[1][0], vA[1][1]);
            PG8_WAIT_V(8); PG8_WAIT_L(0); PG8_BAR; PG8_MMA(0, 0, At, B0); PG8_MMA(0, 1, At, B1); PG8_BAR; PG8_SCHED;
            if (GATHER) { if (last && has_next) {
                int _R, _C; stage_rc((wid * 64 + _ln) * 16, _R, _C); const PG8_LAS int* _tk = (const PG8_LAS int*)(lds + NV_LDS + wid * 1024);
                vA[0][0] = (unsigned)(_tk[_R] * ldab + _C * 2); vA[0][1] = (unsigned)(_tk[_R + 64] * ldab + _C * 2); vA[1][0] = (unsigned)(_tk[HALF + _R] * ldab + _C * 2); vA[1][1] = (unsigned)(_tk[HALF + _R + 64] * ldab + _C * 2); } }
            PG8_LDA(At, 0, 1); PG8_STAGEB(PG8_SB(0, 0), b2); PG8_STAGEB(PG8_SB(0, 1), b2 + hstepB); PG8_STAGE2(PG8_SA(0, 0), a2, vA[0][0], vA[0][1]);
            PG8_WAIT_V(8); PG8_WAIT_L(0); PG8_BAR; PG8_MMA(1, 0, At, B0); PG8_MMA(1, 1, At, B1); PG8_BAR; PG8_SCHED;
            PG8_LDB(B0, 1, 0); PG8_LDB(B1, 1, 1); PG8_SCHED; PG8_LDA(At, 1, 0); PG8_STAGE2(PG8_SA(0, 1), a2, vA[1][0], vA[1][1]);
            PG8_WAIT_V(8); PG8_WAIT_L(0); PG8_BAR; PG8_MMA(0, 0, At, B0); PG8_MMA(0, 1, At, B1); PG8_BAR; PG8_SCHED;
            PG8_LDA(At, 1, 1); PG8_STAGEB(PG8_SB(1, 0), b3); PG8_STAGEB(PG8_SB(1, 1), b3 + hstepB); PG8_STAGE2(PG8_SA(1, 0), a3, vA[0][0], vA[0][1]);
            PG8_WAIT_V(8); PG8_WAIT_L(0); PG8_BAR; PG8_MMA(1, 0, At, B0); PG8_MMA(1, 1, At, B1); PG8_BAR; PG8_SCHED;
        }
        if constexpr (ALIGN_EPI) { if (wr == 0) PG8_BAR; }
        if constexpr (FP8) asm volatile("s_nop 15\n\ts_nop 15" ::: "memory");
        if constexpr (Epi::HAS_PF) E(acc, cur, wr, wc, lds, ui & 1); else E(acc, cur, wr, wc);
        if (!has_next) break;
#pragma unroll
        for (int a = 0; a < 2; ++a)
#pragma unroll
            for (int b = 0; b < 2; ++b)
#pragma unroll
                for (int m = 0; m < 4; ++m)
#pragma unroll
                    for (int n = 0; n < 2; ++n) acc[a][b][m][n] = (f32x4){0.f, 0.f, 0.f, 0.f};
        cur = nxt; cA = nA; cB = nB; ++ui;
        if constexpr (ALIGN_EPI) { if (wr == 1) PG8_BAR; }
    }
    PG8_WAIT_V(0);
    if constexpr (!ALIGN_EPI) { if (wr == 0) PG8_BAR; }
    PG8_BAR;
#undef PG8_SA
#undef PG8_SB
#undef PG8_STAGE2
#undef PG8_STAGEB
#undef PG8_MKA
#undef PG8_LANE_OFFS
#undef PG8_LDA
#undef PG8_LDB
#undef PG8_MMA
#undef PG8_LO
#undef PG8_HI
#undef PG8_WAIT_V
#undef PG8_WAIT_L
#undef PG8_BAR
#undef PG8_SCHED
}

__device__ __forceinline__ unsigned pk4_fp8(float a, float b, float c, float d) { unsigned w = 0; w = __builtin_amdgcn_cvt_pk_fp8_f32(a, b, w, false); w = __builtin_amdgcn_cvt_pk_fp8_f32(c, d, w, true); return w; }
struct EpiProj {
    static constexpr bool PERM = true; static constexpr bool HAS_PF = false;
    bf16_t* proj; float* r6;
    __device__ __forceinline__ void operator()(const f32x4 (&acc)[2][2][4][2], const Unit& u, int wr, int wc) const {
        const int lane__ = lane_now(), fr = lane__ & 15, fq = lane__ >> 4;
        const int row0 = u.pm * BM + wr * 64 + fr; const int colt = C_QI + u.pn * BM + wc * 32 + 8 * fq;
        if (u.pn == 2) {
#pragma unroll
            for (int ai = 0; ai < 2; ++ai)
#pragma unroll
                for (int m = 0; m < 4; ++m) { float* rowp = r6 + (size_t)(row0 + ai * HALF + m * 16) * 256 + wc * 32 + 8 * fq;
#pragma unroll
                    for (int bj = 0; bj < 2; ++bj) { *(f32x4*)(rowp + bj * HALF) = acc[ai][bj][m][0]; *(f32x4*)(rowp + bj * HALF + 4) = acc[ai][bj][m][1]; } }
            return;
        }
#pragma unroll
        for (int ai = 0; ai < 2; ++ai)
#pragma unroll
            for (int m = 0; m < 4; ++m) { bf16_t* rowp = proj + (size_t)(row0 + ai * HALF + m * 16) * PP + colt;
#pragma unroll
                for (int bj = 0; bj < 2; ++bj) { f32x4 v0 = acc[ai][bj][m][0], v1 = acc[ai][bj][m][1];
                    v4u w; w.x = cvt_pk_bf16(v0[0], v0[1]); w.y = cvt_pk_bf16(v0[2], v0[3]); w.z = cvt_pk_bf16(v1[0], v1[1]); w.w = cvt_pk_bf16(v1[2], v1[3]);
                    *(v4u*)(rowp + bj * HALF) = w; } }
    }
};
__device__ __forceinline__ f32x2 lo2(const f32x4& v) { return __builtin_shufflevector(v, v, 0, 1); }
__device__ __forceinline__ f32x2 hi2(const f32x4& v) { return __builtin_shufflevector(v, v, 2, 3); }
__device__ __forceinline__ unsigned pk4_fp8v(f32x2 a, f32x2 b) { return pk4_fp8(a[0], a[1], b[0], b[1]); }
__device__ __forceinline__ v4u widen16(v2u a, v2u b) {
    const auto rx = __builtin_amdgcn_permlane16_swap(a.x, b.x, false, false), ry = __builtin_amdgcn_permlane16_swap(a.y, b.y, false, false);
    return (v4u){rx[0], ry[0], rx[1], ry[1]};
}
__device__ __forceinline__ void unwiden16(v4u L, v2u& a, v2u& b) {
    const auto rx = __builtin_amdgcn_permlane16_swap(L.x, L.z, false, false), ry = __builtin_amdgcn_permlane16_swap(L.y, L.w, false, false);
    a.x = rx[0]; a.y = ry[0]; b.x = rx[1]; b.y = ry[1];
}
constexpr int GATE8_OFF = 2 * C_GA;
struct EpiGate8 {
    static constexpr bool PERM = true; static constexpr bool HAS_PF = false;
    bf16_t* proj;
    __device__ __forceinline__ void operator()(const f32x4 (&acc)[2][2][4][2], const Unit& u, int wr, int wc) const {
        const int lane__ = lane_now(), fr = lane__ & 15, fq = lane__ >> 4;
        const bool isq = u.pn >= 14;
        const int row0 = u.pm * BM + wr * 64 + fr; const int colt = (isq ? C_QLAT + (u.pn - 14) * BM : C_QB + u.pn * BM) + wc * 32 + 8 * fq;
        const bool sg = u.pn >= 6 && !isq; const float sc = (u.pn < 2) ? C2 / SC_WING : 1.0f / SC_WING;
#pragma unroll
        for (int ai = 0; ai < 2; ++ai)
#pragma unroll
            for (int m = 0; m < 4; ++m) { bf16_t* rowp = proj + (size_t)(row0 + ai * HALF + m * 16) * PP + colt;
#pragma unroll
                for (int bj = 0; bj < 2; ++bj) { f32x4 v0 = acc[ai][bj][m][0] * sc, v1 = acc[ai][bj][m][1] * sc;
                    if (sg) {
                        unsigned b0[4], b1[4];
                        const f32x4 e0 = acc[ai][bj][m][0] * (-LOG2E * sc), e1 = acc[ai][bj][m][1] * (-LOG2E * sc);
                        const f32x4 d0 = (f32x4){__builtin_amdgcn_exp2f(e0[0]), __builtin_amdgcn_exp2f(e0[1]), __builtin_amdgcn_exp2f(e0[2]), __builtin_amdgcn_exp2f(e0[3])} + 1.0f;
                        const f32x4 d1 = (f32x4){__builtin_amdgcn_exp2f(e1[0]), __builtin_amdgcn_exp2f(e1[1]), __builtin_amdgcn_exp2f(e1[2]), __builtin_amdgcn_exp2f(e1[3])} + 1.0f;
                        const f32x4 s0 = (f32x4){__builtin_amdgcn_rcpf(d0[0]), __builtin_amdgcn_rcpf(d0[1]), __builtin_amdgcn_rcpf(d0[2]), __builtin_amdgcn_rcpf(d0[3])} * 255.f + 0.5f;
                        const f32x4 s1 = (f32x4){__builtin_amdgcn_rcpf(d1[0]), __builtin_amdgcn_rcpf(d1[1]), __builtin_amdgcn_rcpf(d1[2]), __builtin_amdgcn_rcpf(d1[3])} * 255.f + 0.5f;
#pragma unroll
                        for (int j = 0; j < 4; ++j) { b0[j] = (unsigned)s0[j]; b1[j] = (unsigned)s1[j]; }
                        v2u w; w.x = b0[0] | (b0[1] << 8) | (b0[2] << 16) | (b0[3] << 24); w.y = b1[0] | (b1[1] << 8) | (b1[2] << 16) | (b1[3] << 24);
                        *(v2u*)((unsigned char*)proj + (size_t)(row0 + ai * HALF + m * 16) * (PP * 2) + GATE8_OFF + (u.pn - 6) * BM + wc * 32 + 8 * fq + bj * HALF) = w;
                    } else {
                        v4u w; w.x = cvt_pk_bf16(v0[0], v0[1]); w.y = cvt_pk_bf16(v0[2], v0[3]); w.z = cvt_pk_bf16(v1[0], v1[1]); w.w = cvt_pk_bf16(v1[2], v1[3]);
                        *(v4u*)(rowp + bj * HALF) = w; } } }
    }
};
template <bool ADD> struct EpiMerge {
    static constexpr bool PERM = true; static constexpr bool HAS_PF = false;
    const unsigned char* gate; bf16_t* tb; unsigned char* m8;
    __device__ __forceinline__ void operator()(const f32x4 (&acc)[2][2][4][2], const Unit& u, int wr, int wc) const {
        const int lane__ = lane_now(), fr = lane__ & 15, fq = lane__ >> 4;
        const int row0 = u.pm * BM + wr * 64 + fr; const int colt = u.pn * BM + wc * 32 + 8 * fq;
        const float sc = (ADD ? 1.0f / (SC_YB * SC_WB) : 1.0f / SC_WUVA) * (1.0f / 255.f);
#pragma unroll
        for (int ai = 0; ai < 2; ++ai)
#pragma unroll
            for (int mp = 0; mp < 4; mp += 2) { const size_t rowsel = (size_t)(row0 + ai * HALF + (mp + (fq & 1)) * 16);
#pragma unroll
                for (int bj = 0; bj < 2; ++bj) { const int colw = colt - 8 * (fq & 1) + bj * HALF;
                    v2u g2[2], t2[2], w2[2];
                    unwiden16(*(const v4u*)(gate + rowsel * (PP * 2) + colw), g2[0], g2[1]);
                    unsigned char* tp = (unsigned char*)tb + rowsel * (PP * 2) + colw;
                    if (ADD) unwiden16(*(const v4u*)tp, t2[0], t2[1]);
#pragma unroll
                    for (int mm = 0; mm < 2; ++mm) { const int m = mp + mm; const v2u g = g2[mm];
                        const f32x2 sm_ = (f32x2){sc * SC_M, sc * SC_M};
                        const f32x2 gf0 = (f32x2){(float)(g.x & 0xffu), (float)((g.x >> 8) & 0xffu)}, gf1 = (f32x2){(float)((g.x >> 16) & 0xffu), (float)(g.x >> 24)};
                        const f32x2 gf2 = (f32x2){(float)(g.y & 0xffu), (float)((g.y >> 8) & 0xffu)}, gf3 = (f32x2){(float)((g.y >> 16) & 0xffu), (float)(g.y >> 24)};
                        const f32x4 a0 = acc[ai][bj][m][0], a1 = acc[ai][bj][m][1];
                        if (ADD) { const v2u t = t2[mm];
                            const f32x2 t0 = __builtin_amdgcn_cvt_pk_f32_fp8(t.x, false), t1 = __builtin_amdgcn_cvt_pk_f32_fp8(t.x, true), t2_ = __builtin_amdgcn_cvt_pk_f32_fp8(t.y, false), t3 = __builtin_amdgcn_cvt_pk_f32_fp8(t.y, true);
                            w2[mm].x = pk4_fp8v(__builtin_elementwise_fma(lo2(a0) * sm_, gf0, t0), __builtin_elementwise_fma(hi2(a0) * sm_, gf1, t1));
                            w2[mm].y = pk4_fp8v(__builtin_elementwise_fma(lo2(a1) * sm_, gf2, t2_), __builtin_elementwise_fma(hi2(a1) * sm_, gf3, t3));
                        } else {
                            w2[mm].x = pk4_fp8v(lo2(a0) * sm_ * gf0, hi2(a0) * sm_ * gf1); w2[mm].y = pk4_fp8v(lo2(a1) * sm_ * gf2, hi2(a1) * sm_ * gf3); } }
                    if (ADD) *(v4u*)(m8 + rowsel * 1024 + colw) = widen16(w2[0], w2[1]); else *(v4u*)tp = widen16(w2[0], w2[1]); } }
    }
};
struct EpiOut {
    static constexpr bool PERM = true; static constexpr bool HAS_PF = false;
    const bf16_t* xb; bf16_t* pre;
    __device__ __forceinline__ void operator()(const f32x4 (&acc)[2][2][4][2], const Unit& u, int wr, int wc) const {
        const int lane__ = lane_now(), fr = lane__ & 15, fq = lane__ >> 4;
        const int row0 = u.pm * BM + wr * 64 + fr; const int colt = u.pn * BM + wc * 32 + 8 * fq;
        const float sc = 1.0f / (SC_M * SC_WOUT);
#pragma unroll
        for (int ai = 0; ai < 2; ++ai)
#pragma unroll
            for (int m = 0; m < 4; ++m) { const size_t row = (size_t)(row0 + ai * HALF + m * 16);
#pragma unroll
                for (int bj = 0; bj < 2; ++bj) { const v4u g = *(const v4u*)(xb + row * 1024 + colt + bj * HALF);
                    f32x4 v0 = acc[ai][bj][m][0] * sc, v1 = acc[ai][bj][m][1] * sc;
                    v0[0] += DN_ALPHA * bf_lo(g.x); v0[1] += DN_ALPHA * bf_hi(g.x); v0[2] += DN_ALPHA * bf_lo(g.y); v0[3] += DN_ALPHA * bf_hi(g.y);
                    v1[0] += DN_ALPHA * bf_lo(g.z); v1[1] += DN_ALPHA * bf_hi(g.z); v1[2] += DN_ALPHA * bf_lo(g.w); v1[3] += DN_ALPHA * bf_hi(g.w);
                    v4u w; w.x = cvt_pk_bf16(v0[0], v0[1]); w.y = cvt_pk_bf16(v0[2], v0[3]); w.z = cvt_pk_bf16(v1[0], v1[1]); w.w = cvt_pk_bf16(v1[2], v1[3]);
                    *(v4u*)(pre + row * 1024 + colt + bj * HALF) = w; } }
    }
};
struct EpiGU {
    static constexpr bool PERM = true; static constexpr bool HAS_PF = true;
    const float* bg; const float* bu; unsigned char* hbuf;
    __device__ __forceinline__ void prefetch(PG8_LAS unsigned char* lds, const Unit& u, int wid, int par) const {
        if (wid == 0) { const int l = lane_now(); const float* src = ((l < 32) ? bg : bu) + u.e * DFF + u.pn * HALF + 4 * (l & 31);
            __builtin_amdgcn_global_load_lds((const unsigned*)src, (PG8_LAS unsigned*)(lds + EPG_LDS + par * 1024), 16, 0, 0); }
    }
    __device__ __forceinline__ void operator()(const f32x4 (&acc)[2][2][4][2], const Unit& u, int wr, int wc, PG8_LAS unsigned char* lds, int par) const {
        const int lane__ = lane_now(), fr = lane__ & 15, fq = lane__ >> 4;
        const int ff0 = u.pn * HALF + wc * 32 + 8 * fq;
        const PG8_LAS float* bl = (const PG8_LAS float*)(lds + EPG_LDS + par * 1024) + wc * 32 + 8 * fq;
        const f32x4 g0 = *(const PG8_LAS f32x4*)bl, g1 = *(const PG8_LAS f32x4*)(bl + 4), u0 = *(const PG8_LAS f32x4*)(bl + 128), u1 = *(const PG8_LAS f32x4*)(bl + 132);
#pragma unroll
        for (int ai = 0; ai < 2; ++ai)
#pragma unroll
            for (int mp = 0; mp < 4; mp += 2) { v2u w2[2];
#pragma unroll
                for (int mm = 0; mm < 2; ++mm) { const int m = mp + mm;
                    float hv[8];
#pragma unroll
                    for (int n = 0; n < 2; ++n) { const f32x4 gv = acc[ai][0][m][n] * W8_INV + (n ? g1 : g0), uv = acc[ai][1][m][n] * W8_INV + (n ? u1 : u0);
#pragma unroll
                        for (int j2 = 0; j2 < 4; j2 += 2) {
                            const f32x2 hg = (f32x2){fminf(gv[j2], 7.0f), fminf(gv[j2 + 1], 7.0f)}, hu = (f32x2){fminf(fmaxf(uv[j2], -7.0f), 7.0f), fminf(fmaxf(uv[j2 + 1], -7.0f), 7.0f)};
                            const f32x2 ea = hg * (-1.702f * LOG2E);
                            const f32x2 dn = (f32x2){__builtin_amdgcn_exp2f(ea[0]), __builtin_amdgcn_exp2f(ea[1])} + 1.0f;
                            const f32x2 tt = hg * (f32x2){__builtin_amdgcn_rcpf(dn[0]), __builtin_amdgcn_rcpf(dn[1])};
                            const f32x2 hh = __builtin_elementwise_fma(hu, tt, tt);
                            hv[4 * n + j2] = hh[0]; hv[4 * n + j2 + 1] = hh[1]; } }
                    w2[mm].x = pk4_fp8(hv[0], hv[1], hv[2], hv[3]); w2[mm].y = pk4_fp8(hv[4], hv[5], hv[6], hv[7]); }
                const size_t row = (size_t)(u.pm * BM + ai * HALF + wr * 64 + (mp + (fq & 1)) * 16 + fr);
                *(v4u*)(hbuf + row * 1024 + (ff0 - 8 * (fq & 1))) = widen16(w2[0], w2[1]); }
    }
};
struct EpiDown {
    static constexpr bool PERM = true; static constexpr bool HAS_PF = true;
    const float* bd; const float* gates; const int* slots; unsigned char* ybuf;
    __device__ __forceinline__ void prefetch(PG8_LAS unsigned char* lds, const Unit& u, int wid, int par) const {
        if (wid < 2) { const void* src = (wid == 0) ? (const void*)(slots + (size_t)u.gt * 256 + 4 * lane_now()) : (const void*)(gates + (size_t)u.gt * 256 + 4 * lane_now());
            __builtin_amdgcn_global_load_lds((const unsigned*)src, (PG8_LAS unsigned*)(lds + NV_LDS + par * 2048 + wid * 1024), 16, 0, 0); }
    }
    __device__ __forceinline__ void operator()(const f32x4 (&acc)[2][2][4][2], const Unit& u, int wr, int wc, PG8_LAS unsigned char* lds, int par) const {
        const int lane__ = lane_now(), fr = lane__ & 15, fq = lane__ >> 4;
        const int colt = u.pn * BM + wc * 32 + 8 * fq;
        int slot2[2][2]; float gte[2][4];
        const PG8_LAS int* sl = (const PG8_LAS int*)(lds + NV_LDS + par * 2048); const PG8_LAS float* gl = (const PG8_LAS float*)(lds + NV_LDS + par * 2048 + 1024);
#pragma unroll
        for (int ai = 0; ai < 2; ++ai) {
#pragma unroll
            for (int m = 0; m < 4; ++m) gte[ai][m] = gl[ai * HALF + wr * 64 + m * 16 + fr] * SC_Y;
#pragma unroll
            for (int mh = 0; mh < 2; ++mh) slot2[ai][mh] = sl[ai * HALF + wr * 64 + (2 * mh + (fq & 1)) * 16 + fr]; }
        f32x4 bv[2][2];
#pragma unroll
        for (int bj = 0; bj < 2; ++bj) { bv[bj][0] = *(const f32x4*)(bd + u.e * DM + colt + bj * HALF); bv[bj][1] = *(const f32x4*)(bd + u.e * DM + colt + bj * HALF + 4); }
#pragma unroll
        for (int ai = 0; ai < 2; ++ai)
#pragma unroll
            for (int mp = 0; mp < 4; mp += 2) { const long myslot = slot2[ai][mp >> 1];
#pragma unroll
                for (int bj = 0; bj < 2; ++bj) { v2u w2[2];
#pragma unroll
                    for (int mm = 0; mm < 2; ++mm) { const int m = mp + mm; const float gt = gte[ai][m];
                        const f32x2 g2_ = (f32x2){gt, gt}, wi_ = (f32x2){W8_INV, W8_INV};
                        const f32x4 a0 = acc[ai][bj][m][0], a1 = acc[ai][bj][m][1];
                        w2[mm].x = pk4_fp8v(__builtin_elementwise_fma(lo2(a0), wi_, lo2(bv[bj][0])) * g2_, __builtin_elementwise_fma(hi2(a0), wi_, hi2(bv[bj][0])) * g2_);
                        w2[mm].y = pk4_fp8v(__builtin_elementwise_fma(lo2(a1), wi_, lo2(bv[bj][1])) * g2_, __builtin_elementwise_fma(hi2(a1), wi_, hi2(bv[bj][1])) * g2_); }
                    *(v4u*)(ybuf + myslot * 1024 + (colt - 8 * (fq & 1)) + bj * HALF) = widen16(w2[0], w2[1]); } }
    }
};
}

#define XB_TMO      128
#define XB_XCNT(j)  (256  + 64 * (j))
#define XB_XSUB(j)  (1280 + 64 * (j))
#define XB_XGEN(j)  (2304 + 64 * (j))
#define XB_TOP      3328
#define XB_TOPGEN   3392
#define XCD_BAR_WORDS 3456
#define XB_SPIN_CAP (1u << 18)

__device__ __forceinline__ unsigned xb_ld(unsigned* p)              { return __hip_atomic_load(p, __ATOMIC_RELAXED, __HIP_MEMORY_SCOPE_AGENT); }
__device__ __forceinline__ unsigned xb_add(unsigned* p, unsigned v) { return __hip_atomic_fetch_add(p, v, __ATOMIC_RELAXED, __HIP_MEMORY_SCOPE_AGENT); }
__device__ __forceinline__ unsigned xb_xcc_id() { return (unsigned)__builtin_amdgcn_s_getreg((3 << 11) | 20) & 0xFu; }
#define XB_SPIN(cond, bar) do { unsigned _sp = 0; while (cond) { __builtin_amdgcn_s_sleep(1); \
    if ((++_sp & 255u) == 0u) { if (xb_ld(&(bar)[XB_TMO])) break; if (_sp > XB_SPIN_CAP) { atomicAdd(&(bar)[XB_TMO], 1u); break; } } } } while (0)

struct XcdBarrier { unsigned* bar; unsigned x; volatile LAS unsigned* st; };

__device__ __forceinline__ XcdBarrier xcd_barrier_post(unsigned* bar, volatile LAS unsigned* st) {
    XcdBarrier b; b.bar = bar; b.x = xb_xcc_id(); b.st = st;
    if (threadIdx.x == 0) (void)xb_add(&bar[XB_XCNT(b.x)], 1u);
    return b;
}
__device__ __forceinline__ void xcd_barrier_complete(unsigned* bar, unsigned x, unsigned& nloc, unsigned& nx) {
    const unsigned G = gridDim.x * gridDim.y * gridDim.z;
    unsigned sum, cnt, mine, sp = 0u;
    for (;;) {
        sum = 0u; cnt = 0u; mine = 0u;
#pragma unroll
        for (unsigned j = 0; j < 16; ++j) { const unsigned c = xb_ld(&bar[XB_XCNT(j)]); sum += c; cnt += (c > 0u) ? 1u : 0u; mine = (j == x) ? c : mine; }
        if (sum == G) break;
        __builtin_amdgcn_s_sleep(1);
        if ((++sp & 255u) == 0u) { if (xb_ld(&bar[XB_TMO])) break; if (sp > XB_SPIN_CAP) { atomicAdd(&bar[XB_TMO], 1u); break; } }
    }
    nloc = mine > 0u ? mine : 1u; nx = cnt > 0u ? cnt : 1u;
}
__device__ __forceinline__ void xcd_barrier(const XcdBarrier& b) {
    asm volatile("s_waitcnt vmcnt(0)" ::: "memory");
    __syncthreads();
    if (threadIdx.x == 0) {
        unsigned* bar = b.bar;
        __builtin_amdgcn_s_waitcnt(0);
        unsigned nloc = b.st[0], nx = b.st[1];
        if (nloc == 0u) { xcd_barrier_complete(bar, b.x, nloc, nx); b.st[0] = nloc; b.st[1] = nx; }
        const unsigned old = xb_add(&bar[XB_XSUB(b.x)], 1u);
        const unsigned gen = old / nloc;
        if (old + 1u == (gen + 1u) * nloc) {
            __builtin_amdgcn_fence(__ATOMIC_RELEASE, "agent");
            asm volatile("s_waitcnt vmcnt(0)" ::: "memory");
            const unsigned og = xb_add(&bar[XB_TOP], 1u);
            const unsigned tg = og / nx;
            if (og + 1u == (tg + 1u) * nx) xb_add(&bar[XB_TOPGEN], 1u);
            else XB_SPIN(xb_ld(&bar[XB_TOPGEN]) == tg, bar);
            __builtin_amdgcn_fence(__ATOMIC_ACQUIRE, "agent");
            xb_add(&bar[XB_XGEN(b.x)], 1u);
            asm volatile("s_waitcnt vmcnt(0)" ::: "memory");
        } else {
            XB_SPIN(xb_ld(&bar[XB_XGEN(b.x)]) == gen, bar);
            __builtin_amdgcn_fence(__ATOMIC_ACQUIRE, "agent");
            asm volatile("s_waitcnt vmcnt(0)" ::: "memory");
        }
    }
    __syncthreads();
}

struct Args { const float* in[23]; float* out; unsigned char* ws; int ph_lo, ph_hi, li, pad; };
enum { I_X = 0, I_WIN, I_KVG, I_KIG, I_KIB, I_WUK, I_WUV, I_RELB, I_WA, I_WBR, I_WOUT, I_LN1G, I_LN1B, I_WR, I_BR, I_WG, I_BG, I_WU, I_BU, I_WD, I_BD, I_LN2G, I_LN2B };

struct Frame {
    LAS unsigned char* lds;
    unsigned* ctl;
    int tid, lane, wave, vcu, G;
    unsigned char* ws;
};

__device__ __forceinline__ void transpose_item(const float* W, int ldw, int col0, bf16* WT, int K, int row0, float scale, LAS float* scr, int kb, int nb, int lane) {
    const int k0 = 64 * kb, n0 = 32 * nb;
#pragma unroll 8
    for (int i = 0; i < 32; ++i) { const int kk = 2 * i + (lane >> 5); scr[kk * 33 + (lane & 31)] = W[(size_t)(k0 + kk) * ldw + col0 + n0 + (lane & 31)] * scale; }
    LDS_WAIT(); asm volatile("" ::: "memory");
    const int c = lane & 7;
#pragma unroll
    for (int j = 0; j < 4; ++j) { const int n = (lane >> 3) + 8 * j; const LAS float* s = scr + (8 * c) * 33 + n;
        v4u o; o.x = pk2(s[0 * 33], s[1 * 33]); o.y = pk2(s[2 * 33], s[3 * 33]); o.z = pk2(s[4 * 33], s[5 * 33]); o.w = pk2(s[6 * 33], s[7 * 33]);
        *(v4u*)(WT + (size_t)(row0 + n0 + n) * K + k0 + 8 * c) = o; }
    LDS_WAIT(); asm volatile("" ::: "memory");
}

__device__ __forceinline__ void transpose_item8(const float* W, int ldw, int col0, unsigned char* WT, int K, int row0, float scale, LAS float* scr, int kb, int lane) {
    const int k0 = 64 * kb, l3 = lane >> 3, n4 = (lane & 7) * 4;
    f32x4 v[8];
#pragma unroll
    for (int i = 0; i < 8; ++i) v[i] = *(const f32x4*)(W + (size_t)(k0 + l3 + 8 * i) * ldw + col0 + n4);
#pragma unroll
    for (int i = 0; i < 8; ++i)
#pragma unroll
        for (int j = 0; j < 4; ++j) scr[(n4 + j) * 65 + l3 + 8 * i] = v[i][j] * scale;
    LDS_WAIT(); asm volatile("" ::: "memory");
    const int c = lane & 7;
#pragma unroll
    for (int jn = 0; jn < 4; ++jn) { const int n = l3 + 8 * jn; const LAS float* s = scr + n * 65 + 8 * c;
        v2u o; o.x = pg8::pk4_fp8(s[0], s[1], s[2], s[3]); o.y = pg8::pk4_fp8(s[4], s[5], s[6], s[7]);
        *(v2u*)(WT + (size_t)(row0 + n) * K + k0 + 8 * c) = o; }
    LDS_WAIT(); asm volatile("" ::: "memory");
}

__device__ __forceinline__ void p0_prologue(Frame& F, const Args& A) {
    const float* w_in = A.in[I_WIN];
    bf16* Win_t = (bf16*)(F.ws + WS_WIN);
    const int gw = F.vcu * 8 + F.wave, NGW = F.G * 8;
    for (int job = 64 + blockIdx.x; job < 128; job += F.G) {
        LAS float* L1 = (LAS float*)F.lds;
        LAS float* L2 = (LAS float*)(F.lds + 32768);
        const int jj = job & 63, h = jj >> 3, blk = jj & 7;
        const int tx = F.tid & 127, rg = F.tid >> 7;
        if (job < 64) {
            const float* uk = A.in[I_WUK] + (size_t)h * 64 * 128;
            for (int i = F.tid; i < 8192; i += 512) L1[i] = uk[i];
            for (int i = F.tid; i < 8192; i += 512) { const int kk = i >> 6, d = i & 63; L2[d * 129 + kk] = w_in[(size_t)(blk * 128 + kk) * WIN_LD + h * 64 + d]; }
        } else {
            const float* uv = A.in[I_WUV] + (size_t)h * 128 * 64;
            for (int i = F.tid; i < 8192; i += 512) { const int r = i >> 6, d = i & 63; L1[d * 128 + r] = uv[i]; }
            const float* wa = A.in[I_WA];
            for (int i = F.tid; i < 8192; i += 512) { const int d = i >> 7, nn = i & 127; L2[d * 129 + nn] = wa[(size_t)(h * 64 + d) * 1024 + blk * 128 + nn]; }
        }
        __syncthreads();
        float acc[32];
#pragma unroll
        for (int j = 0; j < 32; ++j) acc[j] = 0.f;
#pragma unroll 2
        for (int d = 0; d < 64; ++d) {
            const float xv = L2[d * 129 + tx];
#pragma unroll
            for (int j4 = 0; j4 < 8; ++j4) { const f32x4 u = *(const LAS f32x4*)(L1 + d * 128 + rg * 32 + 4 * j4); acc[4 * j4] += xv * u[0]; acc[4 * j4 + 1] += xv * u[1]; acc[4 * j4 + 2] += xv * u[2]; acc[4 * j4 + 3] += xv * u[3]; }
        }
        if (job < 64) {
#pragma unroll
            for (int j = 0; j < 32; ++j) Win_t[(size_t)(h * 128 + rg * 32 + j) * 1024 + blk * 128 + tx] = (bf16)f2bf(acc[j] * C2);
        } else {
            unsigned char* Wuva8 = F.ws + WS_WUVA8;
#pragma unroll
            for (int j16 = 0; j16 < 2; ++j16) { v4u o;
                o.x = pg8::pk4_fp8(acc[16 * j16] * SC_WUVA, acc[16 * j16 + 1] * SC_WUVA, acc[16 * j16 + 2] * SC_WUVA, acc[16 * j16 + 3] * SC_WUVA);
                o.y = pg8::pk4_fp8(acc[16 * j16 + 4] * SC_WUVA, acc[16 * j16 + 5] * SC_WUVA, acc[16 * j16 + 6] * SC_WUVA, acc[16 * j16 + 7] * SC_WUVA);
                o.z = pg8::pk4_fp8(acc[16 * j16 + 8] * SC_WUVA, acc[16 * j16 + 9] * SC_WUVA, acc[16 * j16 + 10] * SC_WUVA, acc[16 * j16 + 11] * SC_WUVA);
                o.w = pg8::pk4_fp8(acc[16 * j16 + 12] * SC_WUVA, acc[16 * j16 + 13] * SC_WUVA, acc[16 * j16 + 14] * SC_WUVA, acc[16 * j16 + 15] * SC_WUVA);
                *(v4u*)(Wuva8 + (size_t)(blk * 128 + tx) * 1024 + h * 128 + rg * 32 + 16 * j16) = o; }
        }
        __syncthreads();
    }
    __syncthreads();
    {
        LAS float* scr = (LAS float*)(F.lds + F.wave * 16384);
        constexpr int NI_WIN = 22 * 16, NI_G8 = 128 * 16, NI_WB = 8 * 32, NI_WO = 16 * 32;
        for (int it = gw; it < NI_WIN + NI_G8 + NI_WB + NI_WO; it += NGW) {
            int r = it;
            if (r < NI_WIN) {
                const int nbk = r >> 4, kb = r & 15;
                int col0, row0, nb;
                if (nbk < 16) { col0 = 640; row0 = WR_QI; nb = nbk; }
                else if (nbk < 20) { col0 = 512; row0 = WR_T6; nb = nbk - 16; }
                else { col0 = 1152; row0 = WR_T6 + 128; nb = nbk - 20; }
                transpose_item(w_in, WIN_LD, col0, Win_t, 1024, row0, 1.f, scr, kb, nb, F.lane);
                continue;
            }
            r -= NI_WIN;
            if (r < NI_G8) { const int nb8 = r >> 4; transpose_item8(w_in, WIN_LD, nb8 < 112 ? 1224 + 32 * nb8 : 32 * (nb8 - 112), F.ws + WS_WING8, 1024, 32 * nb8, SC_WING, scr, r & 15, F.lane); continue; }
            r -= NI_G8;
            if (r < NI_WB) { transpose_item8(A.in[I_WBR], 1024, 32 * (r >> 3), F.ws + WS_WB8, 512, 32 * (r >> 3), SC_WB, scr, r & 7, F.lane); continue; }
            r -= NI_WB;
            transpose_item8(A.in[I_WOUT], 1024, 32 * (r >> 4), F.ws + WS_WOUT8, 1024, 32 * (r >> 4), SC_WOUT, scr, r & 15, F.lane);
        }
    }
    const size_t gt = (size_t)blockIdx.x * 512 + F.tid, NT = (size_t)F.G * 512;
    for (size_t i = gt; i < 65536; i += NT) { const int n = WR_T6 + 192 + (int)(i >> 10), k = (int)(i & 1023);
        const float v = (n < WR_T6 + 200) ? w_in[(size_t)k * WIN_LD + 1216 + (n - WR_T6 - 192)] : 0.f; Win_t[(size_t)n * 1024 + k] = (bf16)f2bf(v); }
    { bf16* wukt = (bf16*)(F.ws + WS_WUKT); const float* wuk = A.in[I_WUK];
      for (size_t i = gt; i < 65536; i += NT) { const int hd = (int)(i >> 13), rho = (int)(i >> 6) & 127, k = (int)(i & 63);
          const int bb = rho >> 5, rr = rho & 31, ii = ((rr >> 3) << 2) | (rr & 3), hh = (rr >> 2) & 1, delta = 16 * (2 * bb + (ii >> 3)) + 8 * hh + (ii & 7);
          wukt[i] = (bf16)f2bf(wuk[((size_t)hd * 64 + k) * 128 + delta] * C2); } }
    { bf16* wrh = (bf16*)(F.ws + WS_WRT); float* rc = (float*)(F.ws + WS_WRT + 131072); const float* wr = A.in[I_WR]; const float* lg1 = A.in[I_LN1G]; const float* lb1 = A.in[I_LN1B];
      for (size_t i = gt; i < 32768; i += NT) { const int e = (int)(i >> 10), k = (int)(i & 1023); const float v = lg1[k] * wr[(size_t)k * 32 + e];
          const unsigned hh = f2bf(v); const unsigned ll = f2bf(v - __uint_as_float(hh << 16)); wrh[(size_t)e * 1024 + k] = (bf16)hh; wrh[(size_t)(32 + e) * 1024 + k] = (bf16)ll; }
      if (gw < 32) { const int e = gw; float s1 = 0.f, s2 = 0.f;
          for (int k = F.lane; k < 1024; k += 64) { const float wv = wr[(size_t)k * 32 + e]; const float v = lg1[k] * wv; const unsigned hh = f2bf(v); const float hf = __uint_as_float(hh << 16); const unsigned ll = f2bf(v - hf);
              s1 += hf + __uint_as_float(ll << 16); s2 += lb1[k] * wv; }
          s1 = wave_sum(s1); s2 = wave_sum(s2); if (F.lane == 0) { rc[e] = s1; rc[32 + e] = s2; } } }
    { const float* x = A.in[I_X]; bf16* xb = (bf16*)(F.ws + WS_XB); unsigned char* x8 = F.ws + WS_X8;
      for (size_t i = gt; i < (size_t)NTOK * DM / 8; i += NT) { const f32x4 a = *(const f32x4*)(x + i * 8), b = *(const f32x4*)(x + i * 8 + 4);
          v4u o; o.x = pk2(a[0], a[1]); o.y = pk2(a[2], a[3]); o.z = pk2(b[0], b[1]); o.w = pk2(b[2], b[3]); *(v4u*)(xb + i * 8) = o;
          v2u q8; q8.x = pg8::pk4_fp8(a[0], a[1], a[2], a[3]); q8.y = pg8::pk4_fp8(b[0], b[1], b[2], b[3]); *(v2u*)(x8 + i * 8) = q8; } }
}

__device__ __forceinline__ void p1b_norms(Frame& F, const Args& A) {
    const float* r6 = A.out;
    bf16* ckv = (bf16*)(F.ws + WS_CKV); bf16* kidx = (bf16*)(F.ws + WS_KIDX); float* widx = (float*)(F.ws + WS_WIDX);
    const float g0 = A.in[I_KVG][2 * F.lane], g1 = A.in[I_KVG][2 * F.lane + 1];
    const float kg = A.in[I_KIG][F.lane], kb = A.in[I_KIB][F.lane];
    const int gw = F.vcu * 8 + F.wave, NGW = F.G * 8;
    for (int row0 = gw; row0 < NTOK; row0 += 4 * NGW) {
        f32x2 c[4]; float k[4], w[4];
#pragma unroll
        for (int i = 0; i < 4; ++i) { const int rl = row0 + i * NGW; const float* rp = r6 + (size_t)(rl < NTOK ? rl : NTOK - 1) * 256;
            c[i] = *(const f32x2*)(rp + 2 * F.lane); k[i] = rp[128 + F.lane]; w[i] = rp[192 + (F.lane & 7)]; }
#pragma unroll
        for (int i = 0; i < 4; ++i) { const int row = row0 + i * NGW; if (row >= NTOK) break;
            const float ms = wave_sum(c[i][0] * c[i][0] + c[i][1] * c[i][1]) * (1.f / 128.f); const float rs = 1.0f / sqrtf(ms + LN_EPS);
            *(unsigned*)(ckv + (size_t)row * 128 + 2 * F.lane) = pk2(c[i][0] * rs * g0, c[i][1] * rs * g1);
            const float mu = wave_sum(k[i]) * (1.f / 64.f); const float dk = k[i] - mu; const float var = wave_sum(dk * dk) * (1.f / 64.f);
            kidx[(size_t)row * 64 + F.lane] = (bf16)f2bf(dk * (1.0f / sqrtf(var + LN_EPS)) * kg + kb);
            if (F.lane < 8) widx[(size_t)row * 8 + F.lane] = w[i] * IDX_SCALE; }
    }
}

#define MFMA32(a, b, c) __builtin_amdgcn_mfma_f32_32x32x16_bf16((a), (b), (c), 0, 0, 0)
__device__ __forceinline__ int crow(int r, int hi) { return (r & 3) + 8 * (r >> 2) + 4 * hi; }
__device__ __forceinline__ bf16x8 pack8(const f32x16& x, int s) {
    v4u p; p.x = cvt_pk_bf16(x[8 * s], x[8 * s + 1]); p.y = cvt_pk_bf16(x[8 * s + 2], x[8 * s + 3]); p.z = cvt_pk_bf16(x[8 * s + 4], x[8 * s + 5]); p.w = cvt_pk_bf16(x[8 * s + 6], x[8 * s + 7]);
    return __builtin_bit_cast(bf16x8, p);
}
__device__ __forceinline__ float xsum32(float x) { auto r = __builtin_amdgcn_permlane32_swap(__float_as_uint(x), __float_as_uint(x), false, false); return __uint_as_float(r[0]) + __uint_as_float(r[1]); }
__device__ __forceinline__ float xsum16(float x) { auto r = __builtin_amdgcn_permlane16_swap(__float_as_uint(x), __float_as_uint(x), false, false); return __uint_as_float(r[0]) + __uint_as_float(r[1]); }
__device__ __forceinline__ float xmax32(float x) { auto r = __builtin_amdgcn_permlane32_swap(__float_as_uint(x), __float_as_uint(x), false, false); return fmaxf(__uint_as_float(r[0]), __uint_as_float(r[1])); }
__device__ __forceinline__ float xmax16(float x) { auto r = __builtin_amdgcn_permlane16_swap(__float_as_uint(x), __float_as_uint(x), false, false); return fmaxf(__uint_as_float(r[0]), __uint_as_float(r[1])); }
__device__ __forceinline__ float xmin32(float x) { auto r = __builtin_amdgcn_permlane32_swap(__float_as_uint(x), __float_as_uint(x), false, false); return fminf(__uint_as_float(r[0]), __uint_as_float(r[1])); }
__device__ __forceinline__ float xmin16(float x) { auto r = __builtin_amdgcn_permlane16_swap(__float_as_uint(x), __float_as_uint(x), false, false); return fminf(__uint_as_float(r[0]), __uint_as_float(r[1])); }
__device__ __forceinline__ unsigned xadd32u(unsigned x) { auto r = __builtin_amdgcn_permlane32_swap(x, x, false, false); return r[0] + r[1]; }
__device__ __forceinline__ unsigned xadd16u(unsigned x) { auto r = __builtin_amdgcn_permlane16_swap(x, x, false, false); return r[0] + r[1]; }
__device__ __forceinline__ unsigned xor32u(unsigned x) { auto r = __builtin_amdgcn_permlane32_swap(x, x, false, false); return r[0] | r[1]; }
constexpr int A_QI = 0;
constexpr int A_MASK = 49152;
constexpr int A_CNT = 57344;
constexpr int A_MM = 59392;
constexpr int A_BIAS = 61440;
constexpr float RESCALE_THR = 8.0f;
constexpr int A_END = 69888;
constexpr int A_LIST = 69888;
constexpr int B_WAVE_BYTES = 10752, B_HI_OFF = 73728;
constexpr int A_KV = 0;
typedef short s16x4 __attribute__((ext_vector_type(4)));
__device__ __forceinline__ s16x4 vtr(const LAS unsigned char* p) { return __builtin_bit_cast(s16x4, __builtin_amdgcn_ds_read_tr16_b64_v4i16((LAS s16x4*)p)); }

#define A_COUNT_REDUCE(cnt_local, buf, total) do { unsigned _c = xadd16u(xadd32u(cnt_local)); \
        if (lane < 16) CNT[(buf) * 256 + q16 * 8 + F.wave] = _c; __syncthreads(); \
        { const v4u _a = *(const LAS v4u*)(CNT + (buf) * 256 + q16 * 8), _b = *(const LAS v4u*)(CNT + (buf) * 256 + q16 * 8 + 4); total = (_a.x + _a.y) + (_a.z + _a.w) + (_b.x + _b.y) + (_b.z + _b.w); } } while (0)

__device__ __forceinline__ void a_unit(Frame& F, int b, int qb32) {
    const bf16* proj = (const bf16*)(F.ws + WS_PROJ);
    const bf16* ckv = (const bf16*)(F.ws + WS_CKV); const bf16* kidx = (const bf16*)(F.ws + WS_KIDX); const float* widx = (const float*)(F.ws + WS_WIDX);
    const int c = qb32 >> 1, ntile = 2 * (c + 1);
    const size_t t0 = (size_t)b * SEQ + 32 * qb32;
    int lane = F.lane, tid_ = F.tid; asm volatile("" : "+v"(lane), "+v"(tid_));
    const int q = lane & 31, hi = lane >> 5;
    LAS bf16* QI = (LAS bf16*)(F.lds + A_QI); LAS unsigned* MASK = (LAS unsigned*)(F.lds + A_MASK); LAS unsigned* CNT = (LAS unsigned*)(F.lds + A_CNT); LAS float* MM = (LAS float*)(F.lds + A_MM);
    bf16x8 qv_early[4];
#pragma unroll
    for (int ks = 0; ks < 4; ++ks) qv_early[ks] = *(const bf16x8*)(proj + t0 * PP + C_QLAT + F.wave * 64 + ((unsigned)(q * PP + 8 * hi) + 16 * ks));
#pragma unroll
    for (int i = 0; i < 4; ++i) { const int p = tid_ + 512 * i, row = p >> 6, cc = p & 63; const v4u v = *(const v4u*)(proj + t0 * PP + C_QI + (unsigned)(row * PP + cc * 8)); *(LAS v4u*)(QI + row * 520 + cc * 8) = v; }
    __syncthreads();
    const int q16 = lane & 15, hs = (lane >> 4) & 1;
    const unsigned kl_off = (unsigned)(q * 64 + 8 * hi), ql_off = (unsigned)(q16 * 520 + hs * 64 + 8 * hi);
#ifndef REP_A13
#define REP_A13 1
#endif
#ifndef REP_A4
#define REP_A4 1
#endif
#ifndef REP_B
#define REP_B 1
#endif
    if (ntile <= 8) {
        for (int i = tid_; i < ntile * 32; i += 512) MASK[i] = 0xffffffffu;
    } else
    for (int rp13 = 0; rp13 < REP_A13; ++rp13)
    for (int qh = 0; qh < 2; ++qh) {
        float wq[4];
        { const float* wp = widx + (t0 + 16 * qh) * 8; const unsigned wo = (unsigned)(q16 * 8 + hs); wq[0] = wp[wo]; wq[1] = wp[wo + 2]; wq[2] = wp[wo + 4]; wq[3] = wp[wo + 6]; }
        f32x16 isc[4];
#ifndef REP_S1
#define REP_S1 1
#endif
#ifndef REP_S2
#define REP_S2 1
#endif
        for (int rs1 = 0; rs1 < REP_S1; ++rs1)
#pragma unroll
        for (int u = 0; u < 4; ++u) {
            asm volatile("" ::: "memory");
#pragma unroll
            for (int ab = 0; ab < 2; ++ab) {
                const int T = F.wave + 8 * (2 * u + ab);
                if (T < ntile) {
                    bf16x8 kf[4];
                    const bf16* kb_ = kidx + ((size_t)b * SEQ + 32 * T) * 64;
                    unsigned ko_ = kl_off; asm volatile("" : "+v"(ko_));
#pragma unroll
                    for (int j = 0; j < 4; ++j) kf[j] = *(const bf16x8*)(kb_ + (ko_ + 16 * j));
                    f32x16 part;
#pragma unroll
                    for (int p = 0; p < 4; ++p) {
                        asm volatile("" ::: "memory"); __builtin_amdgcn_sched_barrier(0);
                        f32x16 acc;
#pragma unroll
                        for (int r = 0; r < 16; ++r) acc[r] = 0.f;
#pragma unroll
                        for (int j = 0; j < 4; ++j) acc = MFMA32(kf[j], *(const LAS bf16x8*)(QI + (ql_off + 16 * qh * 520 + p * 128 + 16 * j)), acc);
#pragma unroll
                        for (int r = 0; r < 16; ++r) part[r] = (p == 0) ? wq[0] * fmaxf(acc[r], 0.f) : fmaf(wq[p], fmaxf(acc[r], 0.f), part[r]);
                    }
#pragma unroll
                    for (int r = 0; r < 16; ++r) { const float tot = xsum16(part[r]);
                        if (ab == 0) isc[u][r] = hs ? -INFINITY : tot; else isc[u][r] = hs ? tot : isc[u][r]; }
                } else if (ab == 0) {
#pragma unroll
                    for (int r = 0; r < 16; ++r) isc[u][r] = -INFINITY;
                }
                __builtin_amdgcn_sched_barrier(0);
            }
        }
        float theta = -INFINITY, tieval = __builtin_nanf(""); int tieJ = -1;
        for (int rs2 = 0; rs2 < REP_S2; ++rs2)
        if (ntile > 8) {
            float lmin = INFINITY, lmax = -INFINITY, sm1 = 0.f, sm2 = 0.f;
#pragma unroll
            for (int u = 0; u < 4; ++u) if (F.wave + 16 * u < ntile)
#pragma unroll
                for (int r = 0; r < 16; ++r) { const float v = isc[u][r]; const bool ok = v != -INFINITY; lmin = fminf(lmin, ok ? v : INFINITY); lmax = fmaxf(lmax, v);
                    const float vz = ok ? v : 0.f; sm1 += vz; sm2 = fmaf(vz, vz, sm2); }
            lmin = xmin16(xmin32(lmin)); lmax = xmax16(xmax32(lmax)); sm1 = xsum16(xsum32(sm1)); sm2 = xsum16(xsum32(sm2));
            if (lane < 16) { *(LAS f32x4*)(MM + (q16 * 8 + F.wave) * 4) = (f32x4){lmin, lmax, sm1, sm2}; }
            __syncthreads();
            float lo = INFINITY, hv = -INFINITY, S1 = 0.f, S2 = 0.f;
#pragma unroll
            for (int w = 0; w < 8; ++w) { const f32x4 mm = *(const LAS f32x4*)(MM + (q16 * 8 + w) * 4); lo = fminf(lo, mm[0]); hv = fmaxf(hv, mm[1]); S1 += mm[2]; S2 += mm[3]; }
            hv = fmaxf(hv, 0.f) * 1.0001f + 1e-20f;
            float seed1, seed2;
            { const float nv = (float)(64 * (c + 1)); const float mu = S1 / nv; const float sd = sqrtf(fmaxf(S2 / nv - mu * mu, 0.f));
              const float qq = 0.5f - 256.5f / nv, rr = qq * qq;
              const float zn = (((((-3.969683028665376e+01f * rr + 2.209460984245205e+02f) * rr - 2.759285104469687e+02f) * rr + 1.383577518672690e+02f) * rr - 3.066479806614716e+01f) * rr + 2.506628277459239e+00f) * qq;
              const float zd = ((((-5.447609879822406e+01f * rr + 1.615858368580409e+02f) * rr - 1.556989798598866e+02f) * rr + 6.680131188771972e+01f) * rr - 1.328068155288572e+01f) * rr + 1.0f;
              const float z = zn / zd; seed1 = mu + (z - 0.3f) * sd; seed2 = mu + (z + 0.3f) * sd; }
            bool done = false, tie = false, lfin = false;
            int par = 0;
            float clo = (float)(64 * (c + 1)), chv = 0.f;
            for (int it = 0; it < 200; ++it) {
                const float half = 0.5f * (lo + hv);
                float mid = lo + (hv - lo) * ((clo - 256.5f) / (clo - chv));
                if ((it & 1) || !(mid > lo && mid < hv)) mid = half;
                const float sd_ = (it == 0) ? seed1 : seed2;
                if (it < 2 && sd_ > lo && sd_ < hv) mid = sd_;
                else if (lo < 0.f && hv > 0.f) mid = 0.f;
                else if (lo == 0.f && hv > 1.17549435e-38f) mid = 1.17549435e-38f;
                if (!done && ((lo == 0.f && hv <= 1.17549435e-38f) || mid <= lo || mid >= hv)) { done = true; tie = true; }
                if (__all(done)) break;
                unsigned cl = 0;
#pragma unroll
                for (int u = 0; u < 4; ++u) if (F.wave + 16 * u < ntile)
#pragma unroll
                    for (int r = 0; r < 16; ++r) cl += (isc[u][r] >= mid) ? 1u : 0u;
                unsigned tot; A_COUNT_REDUCE(cl, par, tot); par ^= 1;
                if (!done) { if (tot == 256u) { theta = mid; done = true; } else if (tot > 256u) { lo = mid; clo = (float)tot; } else { hv = mid; chv = (float)tot; }
                    if (!done && clo - chv <= 32.f) { done = true; lfin = true; } }
            }
            if (__any(lfin)) {
                LAS float* LIST = (LAS float*)(F.lds + A_LIST); LAS unsigned* LCNT = (LAS unsigned*)(F.lds + A_LIST + 2048);
                LAS float* QLO = (LAS float*)(F.lds + A_LIST + 2112); LAS float* QHV = QLO + 16; LAS int* QR = (LAS int*)(QHV + 16); LAS float* RESX = (LAS float*)(QR + 16); LAS int* REST = (LAS int*)(RESX + 16);
                if (F.wave == 0 && lane < 16) { LCNT[lane] = 0u; QR[lane] = lfin ? (256 - (int)chv) : 0; }
                __syncthreads();
                if (lfin) {
#pragma unroll
                    for (int u = 0; u < 4; ++u) if (F.wave + 16 * u < ntile)
#pragma unroll
                        for (int r = 0; r < 16; ++r) { const float v = isc[u][r]; if (v >= lo && v < hv) { const unsigned ix = __hip_atomic_fetch_add(LCNT + q16, 1u, __ATOMIC_RELAXED, __HIP_MEMORY_SCOPE_WORKGROUP); LIST[q16 * 32 + (ix & 31u)] = v; } }
                }
                __syncthreads();
                {
                    const int fqq = 2 * F.wave + hi, l = lane & 31; const int cnt = (int)LCNT[fqq], rr = QR[fqq];
                    const float vl = (l < cnt) ? LIST[fqq * 32 + l] : -INFINITY;
                    int gt = 0, eq = 0, before = 0;
#pragma unroll
                    for (int j = 0; j < 32; ++j) { const float vj = (j < cnt) ? LIST[fqq * 32 + j] : -INFINITY; gt += (vj > vl) ? 1 : 0; eq += (vj == vl) ? 1 : 0; before += ((vj == vl) & (j < l)) ? 1 : 0; }
                    if (rr > 0 && l < cnt && gt + before == rr - 1) { RESX[fqq] = vl; REST[fqq] = (gt + eq == rr) ? 0 : 1; }
                }
                __syncthreads();
                if (lfin) { const float x = RESX[q16];
                    if (REST[q16] == 0) theta = x;
                    else { tie = true; lo = x; hv = (x == 0.f) ? 1.17549435e-38f : __int_as_float(__float_as_int(x) + ((x > 0.f) ? 1 : -1)); } }
            }
            if (__any(tie)) {
                unsigned cl = 0;
#pragma unroll
                for (int u = 0; u < 4; ++u) if (F.wave + 16 * u < ntile)
#pragma unroll
                    for (int r = 0; r < 16; ++r) cl += (isc[u][r] >= hv) ? 1u : 0u;
                unsigned cgt; A_COUNT_REDUCE(cl, par, cgt); par ^= 1;
                const int extra = 256 - (int)cgt;
                int jlo = -1, jhi = 2047;
                for (int rd = 0; rd < 11; ++rd) {
                    const int jm = (jlo + jhi) >> 1;
                    unsigned c2 = 0;
#pragma unroll
                    for (int u = 0; u < 4; ++u) if (F.wave + 16 * u < ntile) { const int thr = jm - 32 * (F.wave + 8 * (2 * u + hs)) - 4 * hi;
#pragma unroll
                        for (int r = 0; r < 16; ++r) c2 += ((isc[u][r] == lo) & (crow(r, 0) <= thr)) ? 1u : 0u; }
                    unsigned g; A_COUNT_REDUCE(c2, par, g); par ^= 1;
                    if ((int)g >= extra) jhi = jm; else jlo = jm;
                }
                if (tie) { theta = hv; tieval = lo; tieJ = jhi; }
            }
        }
#pragma unroll
        for (int u = 0; u < 4; ++u) if (F.wave + 16 * u < ntile) { const int T = F.wave + 8 * (2 * u + hs);
            unsigned bits = 0; const int thr = tieJ - 32 * T - 4 * hi;
#pragma unroll
            for (int r = 0; r < 16; ++r) { const float v = isc[u][r]; unsigned sb = ((v >= theta) | ((v == tieval) & (crow(r, 0) <= thr))) ? 1u : 0u; asm volatile("" : "+v"(sb)); bits |= sb << crow(r, 0); }
            bits <<= 4 * hi;
            bits = xor32u(bits);
            if (hi == 0 && T < ntile) MASK[T * 32 + 16 * qh + q16] = bits; }
    }
    __syncthreads();
    for (int rp4 = 0; rp4 < REP_A4; ++rp4) {
        const int h = F.wave;
        LAS unsigned char* KV = F.lds + A_KV;
        const int drow = 4 * F.wave + (lane >> 4); const int dch = (lane & 15) ^ (((drow & 3) << 2) | ((drow >> 2) & 3));
        const bf16* sbase = ckv + (size_t)b * SEQ * 128; const unsigned dsrc = (unsigned)(drow * 128 + dch * 8);
        const unsigned kvw_ = __builtin_amdgcn_readfirstlane((unsigned)(size_t)(KV + 1024 * F.wave));
#define MLA_DMA(SS, SLOTV) do { const bf16* g_ = sbase + (size_t)(2 * (SS)) * (32 * 128) + dsrc; const bf16* g2_ = g_ + 32 * 128; \
            asm volatile("s_mov_b32 m0, %0\n\ts_nop 0\n\tglobal_load_lds_dwordx4 %1, off\n\ts_mov_b32 m0, %2\n\ts_nop 0\n\tglobal_load_lds_dwordx4 %3, off" \
                         :: "s"(kvw_ + (SLOTV)), "v"(g_), "s"(kvw_ + (SLOTV) + 8192u), "v"(g2_) : "memory", "m0"); } while (0)
        MLA_DMA(0, 0u);
        bf16x8 qf[8];
        {
            const bf16* wukt = (const bf16*)(F.ws + WS_WUKT) + h * 8192;
            bf16x8 qv[4];
#pragma unroll
            for (int ks = 0; ks < 4; ++ks) qv[ks] = qv_early[ks];
#pragma unroll
            for (int bb = 0; bb < 4; ++bb) {
                f32x16 cb;
#pragma unroll
                for (int r = 0; r < 16; ++r) cb[r] = 0.f;
#pragma unroll
                for (int ks = 0; ks < 4; ++ks) cb = MFMA32(*(const bf16x8*)(wukt + (unsigned)((32 * bb + q) * 64 + 16 * ks + 8 * hi)), qv[ks], cb);
                qf[2 * bb] = pack8(cb, 0); qf[2 * bb + 1] = pack8(cb, 1);
            }
        }
        f32x16 O[4];
#pragma unroll
        for (int d = 0; d < 4; ++d)
#pragma unroll
            for (int r = 0; r < 16; ++r) O[d][r] = 0.f;
        float m = NEG_BIG, l = 0.f;
        const float slope2 = __builtin_amdgcn_exp2f(-(float)(h + 1)) * LOG2E;
        const float qposf = (float)(32 * qb32 + q);
        const int Xr = ((q & 3) << 2) | ((q >> 2) & 3);
        const unsigned kbase = 256u * q + 16u * (hi ^ Xr);
        const int blk = (lane >> 4) & 1, qq = (lane & 15) >> 2, pp = lane & 3;
        unsigned vb[2];
#pragma unroll
        for (int t = 0; t < 2; ++t) vb[t] = 256u * (8 * t + 4 * hi + qq) + 64u * qq + 16u * ((2 * blk + (pp >> 1)) ^ (2 * t + hi)) + 8u * (pp & 1);
        const int nstep = ntile >> 1;
        asm volatile("s_waitcnt vmcnt(0)" ::: "memory");
        __builtin_amdgcn_s_barrier(); asm volatile("" ::: "memory");
        bf16x8 pa0, pa1, pb0, pb1;
#define MLA_PV(PSLOT) do { \
            _Pragma("unroll") for (int dt = 0; dt < 4; ++dt) { const unsigned x0 = (vb[0] ^ (64u * dt)) + (PSLOT), x1 = (vb[1] ^ (64u * dt)) + (PSLOT);        \
                const s16x4 a0 = vtr(KV + x0), a1 = vtr(KV + x1), a2 = vtr(KV + x0 + 4096), a3 = vtr(KV + x1 + 4096); \
                const s16x4 c0 = vtr(KV + x0 + 8192), c1 = vtr(KV + x1 + 8192), c2 = vtr(KV + x0 + 12288), c3 = vtr(KV + x1 + 12288); \
                const bf16x8 f0 = (bf16x8){a0[0], a0[1], a0[2], a0[3], a1[0], a1[1], a1[2], a1[3]}, f1 = (bf16x8){a2[0], a2[1], a2[2], a2[3], a3[0], a3[1], a3[2], a3[3]}; \
                const bf16x8 g0 = (bf16x8){c0[0], c0[1], c0[2], c0[3], c1[0], c1[1], c1[2], c1[3]}, g1 = (bf16x8){c2[0], c2[1], c2[2], c2[3], c3[0], c3[1], c3[2], c3[3]}; \
                O[dt] = MFMA32(f0, pa0, O[dt]); O[dt] = MFMA32(f1, pa1, O[dt]); O[dt] = MFMA32(g0, pb0, O[dt]); O[dt] = MFMA32(g1, pb1, O[dt]); } } while (0)
#define MLA_STEP(SS, SLOT, PSLOT, NSLOT, HASPV) do { \
            if ((SS) + 1 < nstep) MLA_DMA((SS) + 1, NSLOT); \
            const int T0_ = 2 * (SS); \
            f32x16 Sa, Sb; \
            _Pragma("unroll") for (int r = 0; r < 16; ++r) { Sa[r] = 0.f; Sb[r] = 0.f; } \
            {     \
                bf16x8 kf[4]; \
                _Pragma("unroll") for (int i = 0; i < 4; ++i) kf[i] = *(const LAS bf16x8*)(KV + (kbase ^ (32u * i)) + (SLOT)); \
                _Pragma("unroll") for (int i = 0; i < 16; ++i) { \
                    if (i < 8) Sa = MFMA32(kf[i & 3], qf[i & 7], Sa); else Sb = MFMA32(kf[i & 3], qf[i & 7], Sb); \
                    if (i + 4 < 16) kf[i & 3] = *(const LAS bf16x8*)(KV + (kbase ^ (32u * ((i + 4) & 7))) + (SLOT) + 8192 * ((i + 4) >> 3)); } \
                __builtin_amdgcn_sched_group_barrier(0x100, 4, 0); \
                _Pragma("unroll") for (int i = 0; i < 12; ++i) { __builtin_amdgcn_sched_group_barrier(0x008, 1, 0); __builtin_amdgcn_sched_group_barrier(0x100, 1, 0); } \
                __builtin_amdgcn_sched_group_barrier(0x008, 4, 0); \
                __builtin_amdgcn_sched_barrier(0); \
            } \
            const unsigned mwa = MASK[T0_ * 32 + q] >> (4 * hi), mwb = MASK[(T0_ + 1) * 32 + q] >> (4 * hi); \
            const float dbase = qposf - (float)(32 * T0_ + 4 * hi); \
            float tmax = -INFINITY; \
              \
            _Pragma("unroll") for (int dt = 0; dt < 4; ++dt) { \
                s16x4 a0, a1, a2, a3, c0, c1, c2, c3; \
                if (HASPV) { const unsigned x0 = (vb[0] ^ (64u * dt)) + (PSLOT), x1 = (vb[1] ^ (64u * dt)) + (PSLOT); \
                    a0 = vtr(KV + x0); a1 = vtr(KV + x1); a2 = vtr(KV + x0 + 4096); a3 = vtr(KV + x1 + 4096); \
                    c0 = vtr(KV + x0 + 8192); c1 = vtr(KV + x1 + 8192); c2 = vtr(KV + x0 + 12288); c3 = vtr(KV + x1 + 12288); \
                    __builtin_amdgcn_sched_barrier(0); } \
                _Pragma("unroll") for (int r = 4 * dt; r < 4 * dt + 4; ++r) { const int k0 = crow(r, 0); \
                    float sa_ = Sa[r] - slope2 * fabsf(dbase - (float)k0); sa_ = ((mwa >> k0) & 1u) ? sa_ : -INFINITY; Sa[r] = sa_; \
                    float sb_ = Sb[r] - slope2 * fabsf(dbase - (float)(k0 + 32)); sb_ = ((mwb >> k0) & 1u) ? sb_ : -INFINITY; Sb[r] = sb_; tmax = fmaxf(tmax, fmaxf(sa_, sb_)); } \
                if (HASPV) { __builtin_amdgcn_sched_barrier(0); \
                    const bf16x8 f0 = (bf16x8){a0[0], a0[1], a0[2], a0[3], a1[0], a1[1], a1[2], a1[3]}, f1 = (bf16x8){a2[0], a2[1], a2[2], a2[3], a3[0], a3[1], a3[2], a3[3]}; \
                    const bf16x8 g0 = (bf16x8){c0[0], c0[1], c0[2], c0[3], c1[0], c1[1], c1[2], c1[3]}, g1 = (bf16x8){c2[0], c2[1], c2[2], c2[3], c3[0], c3[1], c3[2], c3[3]}; \
                    O[dt] = MFMA32(f0, pa0, O[dt]); O[dt] = MFMA32(f1, pa1, O[dt]); O[dt] = MFMA32(g0, pb0, O[dt]); O[dt] = MFMA32(g1, pb1, O[dt]); \
                    __builtin_amdgcn_sched_barrier(0); } \
            } \
            tmax = xmax32(tmax); \
            if (__any(tmax - m > RESCALE_THR)) {        \
                const float mn = fmaxf(m, tmax); const float sc = __builtin_amdgcn_exp2f(m - mn); m = mn; l *= sc; \
                _Pragma("unroll") for (int d = 0; d < 4; ++d) _Pragma("unroll") for (int r = 0; r < 16; ++r) O[d][r] *= sc; } \
            float ps = 0.f; \
            _Pragma("unroll") for (int r = 0; r < 16; ++r) { Sa[r] = __builtin_amdgcn_exp2f(Sa[r] - m); Sb[r] = __builtin_amdgcn_exp2f(Sb[r] - m); ps += Sa[r] + Sb[r]; } \
            l += ps; \
            pa0 = pack8(Sa, 0); pa1 = pack8(Sa, 1); pb0 = pack8(Sb, 0); pb1 = pack8(Sb, 1); \
            asm volatile("s_waitcnt vmcnt(0)" ::: "memory"); \
            asm volatile("s_waitcnt lgkmcnt(0)" ::: "memory"); __builtin_amdgcn_s_barrier(); asm volatile("" ::: "memory"); \
        } while (0)
        MLA_STEP(0, 0u, 0u, 16384u, false);
        for (int ss = 1; ss < nstep; ss += 3) { MLA_STEP(ss, 16384u, 0u, 32768u, true); if (ss + 1 < nstep) MLA_STEP(ss + 1, 32768u, 16384u, 0u, true); if (ss + 2 < nstep) MLA_STEP(ss + 2, 0u, 32768u, 16384u, true); }
        { const unsigned lastslot = (unsigned)((nstep - 1) % 3) * 16384u;
          const int ln_ = lane_now(), hi_ = ln_ >> 5, blk_ = (ln_ >> 4) & 1, qq_ = (ln_ & 15) >> 2, pp_ = ln_ & 3;
#pragma unroll
          for (int t = 0; t < 2; ++t) vb[t] = 256u * (8 * t + 4 * hi_ + qq_) + 64u * qq_ + 16u * ((2 * blk_ + (pp_ >> 1)) ^ (2 * t + hi_)) + 8u * (pp_ & 1);
          MLA_PV(lastslot); }
        asm volatile("s_waitcnt lgkmcnt(0)" ::: "memory"); __builtin_amdgcn_s_barrier(); asm volatile("" ::: "memory");
#undef MLA_PV
#undef MLA_STEP
#undef MLA_DMA
        if (rp4 + 1 < REP_A4) continue;
        l = xsum32(l);
        const float inv = 1.0f / l;
        unsigned char* op = F.ws + WS_OL8 + t0 * 1024 + h * 128; const unsigned ol_off = (unsigned)(q * 1024 + 4 * hi);
#pragma unroll
        for (int dt = 0; dt < 4; ++dt)
#pragma unroll
            for (int g = 0; g < 4; ++g) *(unsigned*)(op + (ol_off + 32 * dt + 8 * g)) = pg8::pk4_fp8(O[dt][4 * g] * inv, O[dt][4 * g + 1] * inv, O[dt][4 * g + 2] * inv, O[dt][4 * g + 3] * inv);
    }
}

__device__ __forceinline__ void b_unit(Frame& F, int b, int qb32) {
    const bf16* proj = (const bf16*)(F.ws + WS_PROJ);
    const LAS float* BIAS = (const LAS float*)(F.lds + A_BIAS);
    const int c = qb32 >> 1, h = F.wave;
    const size_t t0 = (size_t)b * SEQ + 32 * qb32;
    int lane = F.lane; asm volatile("" : "+v"(lane));
    const int q = lane & 31, hi = lane >> 5;
    bf16x8 qf[4];
#pragma unroll
    for (int j = 0; j < 4; ++j) qf[j] = *(const bf16x8*)(proj + t0 * PP + C_QB + h * 64 + ((unsigned)(q * PP + 8 * hi) + 16 * j));
    LAS unsigned char* KT = F.lds + (h < 3 ? h * B_WAVE_BYTES : B_HI_OFF + (h - 3) * B_WAVE_BYTES);
    LAS unsigned char* VT = KT + 4608;
    const unsigned g_off = (unsigned)((lane >> 3) * PP + (lane & 7) * 8);
    const unsigned ks_off = (unsigned)((lane >> 3) * 144 + (lane & 7) * 16), vs_off = (unsigned)((lane >> 3) * 192 + (lane & 7) * 16);
    const unsigned kr_off = (unsigned)(q * 144 + 16 * hi);
    const int blk = (lane >> 4) & 1, qq = (lane & 15) >> 2, pp = lane & 3;
    const unsigned vr_off = (unsigned)((4 * hi + qq) * 192 + 32 * blk + 8 * pp);
    f32x16 O[2]; float m, l;
    const float cbias = BIAS[h * 264 + 256];
    for (int rpb = 0; rpb < REP_B; ++rpb) {
#pragma unroll
    for (int d = 0; d < 2; ++d)
#pragma unroll
        for (int r = 0; r < 16; ++r) O[d][r] = 0.f;
    m = NEG_BIG; l = 0.f;
    const int qpos = 32 * qb32 + q;
    const int Tlo = (c > 8) ? 2 * (c - 8) : 0, Thi = 2 * (c + 1);
    v4u kst[4], vst[4];
    { const bf16* gp = proj + ((size_t)b * SEQ + 32 * Tlo) * PP + h * 64;
#pragma unroll
      for (int i = 0; i < 4; ++i) { kst[i] = *(const v4u*)(gp + C_KB + (g_off + i * 8 * PP)); vst[i] = *(const v4u*)(gp + C_VB + (g_off + i * 8 * PP)); }
#pragma unroll
      for (int i = 0; i < 4; ++i) { *(LAS v4u*)(KT + ks_off + i * 8 * 144) = kst[i]; *(LAS v4u*)(VT + vs_off + i * 8 * 192) = vst[i]; }
      asm volatile("" ::: "memory");
      if (Tlo + 1 < Thi) { const bf16* gp2 = gp + (size_t)32 * PP;
#pragma unroll
          for (int i = 0; i < 4; ++i) { kst[i] = *(const v4u*)(gp2 + C_KB + (g_off + i * 8 * PP)); vst[i] = *(const v4u*)(gp2 + C_VB + (g_off + i * 8 * PP)); } } }
    for (int T = Tlo; T < Thi; ++T) {
        f32x16 S;
        const bool farT = (32 * qb32 - 32 * T - 31) >= 128;
        const float s_init = farT ? cbias : 0.f;
#pragma unroll
        for (int r = 0; r < 16; ++r) S[r] = s_init;
#pragma unroll
        for (int j = 0; j < 4; ++j) S = MFMA32(*(const LAS bf16x8*)(KT + kr_off + 32 * j), qf[j], S);
        s16x4 va_[2][4];
#pragma unroll
        for (int dt = 0; dt < 2; ++dt)
#pragma unroll
            for (int k4 = 0; k4 < 4; ++k4) va_[dt][k4] = vtr(VT + vr_off + 64 * dt + 8 * k4 * 192);
        __builtin_amdgcn_sched_barrier(0);
        if (T + 1 < Thi) {
            asm volatile("" ::: "memory");
#pragma unroll
            for (int i = 0; i < 4; ++i) { *(LAS v4u*)(KT + ks_off + i * 8 * 144) = kst[i]; *(LAS v4u*)(VT + vs_off + i * 8 * 192) = vst[i]; }
            asm volatile("" ::: "memory");
            if (T + 2 < Thi) { const bf16* gp = proj + ((size_t)b * SEQ + 32 * (T + 2)) * PP + h * 64;
#pragma unroll
                for (int i = 0; i < 4; ++i) { kst[i] = *(const v4u*)(gp + C_KB + (g_off + i * 8 * PP)); vst[i] = *(const v4u*)(gp + C_VB + (g_off + i * 8 * PP)); } }
            __builtin_amdgcn_sched_barrier(0);
        }
        float tmax = -INFINITY;
        if (farT) {
#pragma unroll
            for (int r = 0; r < 16; ++r) tmax = fmaxf(tmax, S[r]);
        } else {
            const int rbase = qpos - 32 * T - 4 * hi;
#pragma unroll
            for (int r = 0; r < 16; ++r) { const int rel = rbase - crow(r, 0); const int idx = (rel < 128 ? rel : 128) + 128;
                const float s = S[r] + BIAS[h * 264 + idx]; S[r] = s; tmax = fmaxf(tmax, s); }
        }
        tmax = xmax32(tmax);
        if (__any(tmax - m > RESCALE_THR)) {
            const float mn = fmaxf(m, tmax); const float sc = __builtin_amdgcn_exp2f(m - mn); m = mn; l *= sc;
#pragma unroll
            for (int d = 0; d < 2; ++d)
#pragma unroll
                for (int r = 0; r < 16; ++r) O[d][r] *= sc; }
        float ps = 0.f;
#pragma unroll
        for (int r = 0; r < 16; ++r) { S[r] = __builtin_amdgcn_exp2f(S[r] - m); ps += S[r]; }
        l += ps;
        const bf16x8 pf0 = pack8(S, 0), pf1 = pack8(S, 1);
#pragma unroll
        for (int dt = 0; dt < 2; ++dt) {
            const s16x4 a0 = va_[dt][0], a1 = va_[dt][1], a2 = va_[dt][2], a3 = va_[dt][3];
            const bf16x8 f0 = (bf16x8){a0[0], a0[1], a0[2], a0[3], a1[0], a1[1], a1[2], a1[3]}, f1 = (bf16x8){a2[0], a2[1], a2[2], a2[3], a3[0], a3[1], a3[2], a3[3]};
            O[dt] = MFMA32(f0, pf0, O[dt]); O[dt] = MFMA32(f1, pf1, O[dt]);
        }
    }
    }
    l = xsum32(l);
    const float inv = 1.0f / l;
    unsigned char* op = F.ws + WS_YB8 + t0 * 512 + h * 64; const unsigned ol_off = (unsigned)(q * 512 + 4 * hi);
    const float inv16 = inv * SC_YB;
#pragma unroll
    for (int dt = 0; dt < 2; ++dt)
#pragma unroll
        for (int g = 0; g < 4; ++g) *(unsigned*)(op + (ol_off + 32 * dt + 8 * g)) = pg8::pk4_fp8(O[dt][4 * g] * inv16, O[dt][4 * g + 1] * inv16, O[dt][4 * g + 2] * inv16, O[dt][4 * g + 3] * inv16);
}

__device__ __forceinline__ void p2_mixers(Frame& F, const Args& A) {
    LAS float* BIAS = (LAS float*)(F.lds + A_BIAS);
    for (int i = F.tid; i < 8 * 257; i += 512) { const int h = i / 257, k = i % 257; BIAS[h * 264 + k] = A.in[I_RELB][i] * LOG2E; }
    __syncthreads();
    for (int i = 0;; ++i) {
        const int L = i * F.G + F.vcu; if (L >= 2048) break;
        const int rnd = L >> 8, v = L & 255, b = v >> 3, s = v & 7;
        const int j = (rnd & 1) ? (16 * (rnd >> 1) + 15 - s) : (16 * (rnd >> 1) + s);
        a_unit(F, b, j);
        b_unit(F, b, j);
        __syncthreads();
    }
}

constexpr int P6_LOG = RING_BYTES + 1024;
constexpr int P6_HIST = P6_LOG + 8448;
__device__ __forceinline__ void p6_ln1_router(Frame& F, const Args& A) {
    const unsigned char* pre = F.ws + WS_PRE; unsigned char* x1b = F.ws + WS_X1B; unsigned char* x1q = F.ws + WS_X1Q;
    const unsigned char* wrh = F.ws + WS_WRT; const float* rc = (const float*)(F.ws + WS_WRT + 131072);
    int* cnt = (int*)(F.ws + WS_CNT); int* topE = (int*)(F.ws + WS_TOPE); float* topG = (float*)(F.ws + WS_TOPG);
    LAS unsigned char* WL = F.lds;
    LAS float* LOG = (LAS float*)(F.lds + P6_LOG); LAS int* HIST = (LAS int*)(F.lds + P6_HIST); LAS float* MS = (LAS float*)(F.lds + P6_HIST + 256 + F.wave * 64);
    for (int i = F.tid; i < 64 * 128; i += 512) *(LAS v4u*)(WL + (i >> 7) * 2064 + (i & 127) * 16) = *(const v4u*)(wrh + (size_t)i * 16);
    const float c1e = rc[F.lane & 31], c2e = rc[32 + (F.lane & 31)];
    if (F.tid < 32) HIST[F.tid] = 0;
    __syncthreads();
    const int lane = F.lane;
    v2u raw[4][4];
    for (int ch = blockIdx.x; ch < 256; ch += F.G) {
        f32x16 LP;
        { const int ln_ = lane_now(), r_ = ln_ & 31, h_ = ln_ >> 5;
          const unsigned char* ap = pre + (size_t)(ch * 256 + (r_ >> 3) * 64 + F.wave * 8 + (r_ & 7)) * 2048 + 16 * h_;
          const LAS unsigned char* bp = WL + r_ * 2064 + 16 * h_;
          f32x16 C0, C1;
#pragma unroll
          for (int i = 0; i < 16; ++i) { C0[i] = 0.f; C1[i] = 0.f; }
          bf16x8 afa[8], afb[8];
#pragma unroll
          for (int j = 0; j < 8; ++j) afa[j] = *(const bf16x8*)(ap + 32 * j);
#pragma unroll
          for (int c = 0; c < 8; c += 2) {
#pragma unroll
              for (int j = 0; j < 8; ++j) afb[j] = *(const bf16x8*)(ap + 32 * (8 * (c + 1) + j));
#pragma unroll
              for (int j = 0; j < 8; ++j) { const int ks = 8 * c + j; C0 = MFMA32(afa[j], *(const LAS bf16x8*)(bp + 32 * ks), C0); C1 = MFMA32(afa[j], *(const LAS bf16x8*)(bp + 32 * 2064 + 32 * ks), C1); }
              if (c + 2 < 8) {
#pragma unroll
                  for (int j = 0; j < 8; ++j) afa[j] = *(const bf16x8*)(ap + 32 * (8 * (c + 2) + j)); }
#pragma unroll
              for (int j = 0; j < 8; ++j) { const int ks = 8 * (c + 1) + j; C0 = MFMA32(afb[j], *(const LAS bf16x8*)(bp + 32 * ks), C0); C1 = MFMA32(afb[j], *(const LAS bf16x8*)(bp + 32 * 2064 + 32 * ks), C1); }
          }
#pragma unroll
          for (int i = 0; i < 16; ++i) LP[i] = C0[i] + C1[i];
        }
#pragma unroll
        for (int bt = 0; bt < 4; ++bt) {
            const int rowbase = ch * 256 + bt * 64 + F.wave * 8;
#pragma unroll 1
            for (int pr = 0; pr < 2; ++pr) {
                const int row0 = rowbase + 4 * pr;
                unsigned l4 = 4u * (unsigned)lane_now(); asm volatile("" : "+v"(l4)); const unsigned l8 = 2u * l4, l16 = 4u * l4;
#ifdef P6_LITE
                {
#else
                if (bt == 0 && pr == 0) {
#endif
#pragma unroll
                    for (int r = 0; r < 4; ++r)
#pragma unroll
                        for (int j = 0; j < 4; ++j) raw[r][j] = *(const v2u*)(pre + (size_t)(row0 + r) * 2048 + (l8 + 512u * j));
                }
                f32x4 g1[4], b1[4];
#pragma unroll
                for (int j = 0; j < 4; ++j) { g1[j] = *(const f32x4*)((const unsigned char*)A.in[I_LN1G] + (l16 + 1024u * j)); b1[j] = *(const f32x4*)((const unsigned char*)A.in[I_LN1B] + (l16 + 1024u * j)); }
                f32x4 xv[4][4];
#pragma unroll
                for (int r = 0; r < 4; ++r)
#pragma unroll
                    for (int j = 0; j < 4; ++j) xv[r][j] = (f32x4){bf_lo(raw[r][j].x), bf_hi(raw[r][j].x), bf_lo(raw[r][j].y), bf_hi(raw[r][j].y)};
#ifndef P6_LITE
                {
                    const int nrow = (pr == 0) ? row0 + 4 : ((bt < 3) ? row0 + 60 : row0);
#pragma unroll
                    for (int r = 0; r < 4; ++r)
#pragma unroll
                        for (int j = 0; j < 4; ++j) raw[r][j] = *(const v2u*)(pre + (size_t)(nrow + r) * 2048 + (l8 + 512u * j));
                }
#endif
#pragma unroll
                for (int r = 0; r < 4; ++r) {
                    float s = 0.f;
#pragma unroll
                    for (int j = 0; j < 4; ++j) s += (xv[r][j][0] + xv[r][j][1]) + (xv[r][j][2] + xv[r][j][3]);
                    const float mean = wave_sum(s) * (1.f / DM); float s2 = 0.f;
#pragma unroll
                    for (int j = 0; j < 4; ++j) { xv[r][j] = xv[r][j] - mean; s2 += (xv[r][j][0] * xv[r][j][0] + xv[r][j][1] * xv[r][j][1]) + (xv[r][j][2] * xv[r][j][2] + xv[r][j][3] * xv[r][j][3]); }
                    const float rstd = 1.f / sqrtf(wave_sum(s2) * (1.f / DM) + LN_EPS);
                    if (lane_now() == 0) { MS[(4 * pr + r) * 2] = mean; MS[(4 * pr + r) * 2 + 1] = rstd; }
#pragma unroll
                    for (int j = 0; j < 4; ++j) { xv[r][j] = xv[r][j] * rstd * g1[j] + b1[j];
                        { v2u w; w.x = cvt_pk_bf16(xv[r][j][0], xv[r][j][1]); w.y = cvt_pk_bf16(xv[r][j][2], xv[r][j][3]); *(v2u*)(x1b + (size_t)(row0 + r) * 2048 + (l8 + 512u * j)) = w; }
                        *(unsigned*)(x1q + (size_t)(row0 + r) * 1024 + (l4 + 256u * j)) = pg8::pk4_fp8(xv[r][j][0], xv[r][j][1], xv[r][j][2], xv[r][j][3]); }
                }
            }
            {
                const int ln_ = lane_now(), e_ = ln_ & 31, h_ = ln_ >> 5;
#pragma unroll
                for (int j = 0; j < 4; ++j) { const int ri = j + 4 * h_; const float mean = MS[ri * 2], rstd = MS[ri * 2 + 1];
                    LOG[(F.wave * 8 + ri) * 33 + e_] = rstd * (LP[4 * bt + j] - mean * c1e) + c2e; }
            }
            __syncthreads();
            if ((F.wave * 64 + lane_now()) < 64) {
                const int t = ch * 256 + bt * 64 + (F.wave * 64 + lane_now());
                float lg[32];
#pragma unroll
                for (int e = 0; e < 32; ++e) lg[e] = LOG[(F.wave * 64 + lane_now()) * 33 + e] + A.in[I_BR][e];
                int be[4]; float bv[4];
#pragma unroll
                for (int k = 0; k < 4; ++k) { float best = -INFINITY; int bi = 0;
#pragma unroll
                    for (int e = 0; e < 32; ++e) if (lg[e] > best) { best = lg[e]; bi = e; }
#pragma unroll
                    for (int e = 0; e < 32; ++e) if (e == bi) lg[e] = -INFINITY;
                    be[k] = bi; bv[k] = best; }
                float ex[4], sum = 0.f;
#pragma unroll
                for (int k = 0; k < 4; ++k) { ex[k] = __builtin_amdgcn_exp2f((bv[k] - bv[0]) * LOG2E); sum += ex[k]; }
                const float rs = 1.f / sum;
#pragma unroll
                for (int k = 0; k < 4; ++k) { topE[(size_t)t * 4 + k] = be[k]; topG[(size_t)t * 4 + k] = ex[k] * rs; __hip_atomic_fetch_add(HIST + be[k], 1, __ATOMIC_RELAXED, __HIP_MEMORY_SCOPE_WORKGROUP); }
            }
            __syncthreads();
        }
        if ((F.wave * 64 + lane_now()) < 32) { cnt[ch * 32 + (F.wave * 64 + lane_now())] = HIST[(F.wave * 64 + lane_now())]; HIST[(F.wave * 64 + lane_now())] = 0; }
        __syncthreads();
    }
}

__device__ __forceinline__ void p7_convert_dispatch(Frame& F, const Args& A) {
    {
        const int* cnt = (const int*)(F.ws + WS_CNT); const int* topE = (const int*)(F.ws + WS_TOPE); const float* topG = (const float*)(F.ws + WS_TOPG);
        int* toks = (int*)(F.ws + WS_TOKS); float* gates = (float*)(F.ws + WS_GATES); int* slots = (int*)(F.ws + WS_SLOTS); int* pstg = (int*)(F.ws + WS_PST);
        LAS int* PA = (LAS int*)F.lds;
        LAS int* PB = PA + 512;
        LAS int* TOT = PB + 512; LAS int* BEF = TOT + 32; LAS int* PSTL = BEF + 32; LAS int* BASE = PSTL + 40; LAS int* LCNT = BASE + 32;
        for (int ch = blockIdx.x; ch < 256; ch += F.G) {
            { const int e = F.tid & 31, part = F.tid >> 5; int sa = 0, sb = 0;
              for (int c2 = part * 16; c2 < part * 16 + 16; ++c2) { const int v = cnt[c2 * 32 + e]; sa += v; if (c2 < ch) sb += v; }
              PA[part * 32 + e] = sa; PB[part * 32 + e] = sb; }
            __syncthreads();
            if (F.tid < 32) { int sa = 0, sb = 0; for (int p = 0; p < 16; ++p) { sa += PA[p * 32 + F.tid]; sb += PB[p * 32 + F.tid]; } TOT[F.tid] = sa; BEF[F.tid] = sb; }
            __syncthreads();
            if (F.tid == 0) { int ps = 0; for (int e = 0; e < 32; ++e) { PSTL[e] = ps; ps += (TOT[e] + 255) & ~255; } PSTL[32] = ps; }
            __syncthreads();
            if (F.tid < 32) { BASE[F.tid] = PSTL[F.tid] + BEF[F.tid]; LCNT[F.tid] = 0; }
            __syncthreads();
            if (F.tid < 256) { const int t = ch * 256 + F.tid;
#pragma unroll
                for (int k = 0; k < 4; ++k) { const int e = topE[(size_t)t * 4 + k]; const int r = __hip_atomic_fetch_add(LCNT + e, 1, __ATOMIC_RELAXED, __HIP_MEMORY_SCOPE_WORKGROUP);
                    const int pos = BASE[e] + r; toks[pos] = t; gates[pos] = topG[(size_t)t * 4 + k]; slots[pos] = t * 4 + k; } }
            if (ch == 0) {
                for (int idx = F.tid; idx < 32 * 256; idx += 512) { const int e = idx >> 8, o = idx & 255; const int p = PSTL[e] + TOT[e] + o; if (p < PSTL[e + 1]) { toks[p] = 0; gates[p] = 0.f; slots[p] = TRASH_SLOT; } }
                if (F.tid < 33) pstg[F.tid] = PSTL[F.tid];
                { unsigned char* teg = (unsigned char*)(F.ws + WS_TE);
                  for (int idx = F.tid; idx < NTE; idx += 512) { int e = 0; for (int k = 1; k < 32; ++k) if (PSTL[k] <= idx * 256) e = k; teg[idx] = (unsigned char)e; } }
            }
            __syncthreads();
        }
    }
    __syncthreads();
    {
        LAS float* scr = (LAS float*)(F.lds + F.wave * 16384);
        const int gw = F.vcu * 8 + F.wave, NGW = F.G * 8;
        unsigned char* Wgu = F.ws + WS_WGU; unsigned char* Wd = F.ws + WS_WD;
        constexpr int PER_E = 3 * 512;
        for (int it = gw; it < NE * PER_E; it += NGW) {
            const int e = it / PER_E; int r = it % PER_E; const int which = r / 512; r %= 512;
            const int kb = r & 15, nb = r >> 4;
            if (which == 0)      transpose_item8(A.in[I_WG] + (size_t)e * DM * DFF, DFF, 32 * nb, Wgu + (size_t)e * 2048 * 1024, 1024, (nb >> 2) * 256 + (nb & 3) * 32, pg8::W8_SCALE, scr, kb, F.lane);
            else if (which == 1) transpose_item8(A.in[I_WU] + (size_t)e * DM * DFF, DFF, 32 * nb, Wgu + (size_t)e * 2048 * 1024, 1024, (nb >> 2) * 256 + 128 + (nb & 3) * 32, pg8::W8_SCALE, scr, kb, F.lane);
            else                 transpose_item8(A.in[I_WD] + (size_t)e * DFF * DM, DM, 32 * nb, Wd + (size_t)e * 1024 * 1024, 1024, 32 * nb, pg8::W8_SCALE, scr, kb, F.lane);
        }
    }
}

__device__ __forceinline__ void p16_ln2(Frame& F, const Args& A, bool poison) {
    float* xo = A.out; const unsigned char* Y = F.ws + WS_Y; const unsigned char* x1b = F.ws + WS_X1B;
    const int lane = F.lane; const int gw = F.vcu * 8 + F.wave, NGW = F.G * 8;
    f32x4 g2[4], b2[4];
#pragma unroll
    for (int j = 0; j < 4; ++j) { g2[j] = *(const f32x4*)(A.in[I_LN2G] + 4 * lane + 256 * j); b2[j] = *(const f32x4*)(A.in[I_LN2B] + 4 * lane + 256 * j); }
    const float qnan = __builtin_nanf("");
    for (int row = gw; row < NTOK; row += NGW) {
        f32x4 v[4];
#pragma unroll
        for (int j = 0; j < 4; ++j) { const v2u w = *(const v2u*)(x1b + ((size_t)row * DM + 4 * lane + 256 * j) * 2); v[j] = (f32x4){bf_lo(w.x), bf_hi(w.x), bf_lo(w.y), bf_hi(w.y)} * DN_ALPHA; }
#pragma unroll
        for (int k = 0; k < 4; ++k)
#pragma unroll
            for (int j = 0; j < 4; ++j) { const unsigned w = *(const unsigned*)(Y + ((size_t)row * 4 + k) * DM + 4 * lane + 256 * j);
                const f32x2 lo = __builtin_amdgcn_cvt_pk_f32_fp8(w, false), hi2 = __builtin_amdgcn_cvt_pk_f32_fp8(w, true);
                v[j][0] += lo[0] * (1.0f / SC_Y); v[j][1] += lo[1] * (1.0f / SC_Y); v[j][2] += hi2[0] * (1.0f / SC_Y); v[j][3] += hi2[1] * (1.0f / SC_Y); }
        float s = 0.f;
#pragma unroll
        for (int j = 0; j < 4; ++j) s += (v[j][0] + v[j][1]) + (v[j][2] + v[j][3]);
        const float mean = wave_sum(s) * (1.f / DM); float s2 = 0.f;
#pragma unroll
        for (int j = 0; j < 4; ++j) { v[j] = v[j] - mean; s2 += (v[j][0] * v[j][0] + v[j][1] * v[j][1]) + (v[j][2] * v[j][2] + v[j][3] * v[j][3]); }
        const float rstd = 1.f / sqrtf(wave_sum(s2) * (1.f / DM) + LN_EPS);
#pragma unroll
        for (int j = 0; j < 4; ++j) { f32x4 o = v[j] * rstd * g2[j] + b2[j]; if (poison) o = (f32x4){qnan, qnan, qnan, qnan}; *(f32x4*)(xo + (size_t)row * DM + 4 * lane + 256 * j) = o; }
    }
}

constexpr int NPHASE = 11;
#ifndef MOE_ALIGN
#define MOE_ALIGN true
#endif
__global__ void __launch_bounds__(512, 2) mk_fwd(Args args) {
    extern __shared__ __attribute__((aligned(16))) unsigned char lds[];
    Frame F;
    F.lds = (LAS unsigned char*)lds;
    F.wave = __builtin_amdgcn_readfirstlane((int)threadIdx.x >> 6); F.lane = lane_now(); F.tid = F.wave * 64 + F.lane;
#define REFRESH() do { F.lane = lane_now(); F.tid = F.wave * 64 + F.lane; } while (0)
    F.G = gridDim.x; { const int bx = blockIdx.x; F.vcu = (F.G % 8 == 0) ? (bx % 8) * (F.G / 8) + bx / 8 : bx; }
    F.ws = args.ws; F.ctl = (unsigned*)(args.ws + WS_CTL);
    for (int u = F.tid; u < 64; u += 512) ((LAS unsigned*)(F.lds + MISC_OFF))[u] = 0u;
    __syncthreads();
    volatile LAS unsigned* MISC = (volatile LAS unsigned*)(F.lds + MISC_OFF);
    XcdBarrier bar = xcd_barrier_post(F.ctl + CW_BAR + args.li * XCD_BAR_WORDS, MISC + 8);
    const int lo = args.ph_lo, hi = args.ph_hi;
#define IN(k) (lo <= (k) && (k) < hi)
#define SEAM(k) do { if (IN(k) && IN((k) + 1)) xcd_barrier(bar); } while (0)
    unsigned char* ws = args.ws;
    const pg8::bf16_t* proj = (const pg8::bf16_t*)(ws + WS_PROJ);

#ifndef REP_P0
#define REP_P0 1
#endif
#ifndef REP_A
#define REP_A 1
#endif
#ifndef REP_P1
#define REP_P1 1
#endif
#ifndef REP_34
#define REP_34 1
#endif
#ifndef REP_56
#define REP_56 1
#endif
#ifndef REP_5
#define REP_5 1
#endif
#ifndef REP_7
#define REP_7 1
#endif
#ifndef REP_MOE
#define REP_MOE 1
#endif
    for (int r0 = 0; r0 < REP_P0; ++r0) {
        if (IN(0)) { REFRESH(); p0_prologue(F, args); }
        SEAM(0);
    }
    for (int ra = 0; ra < REP_A; ++ra) {
        for (int r1 = 0; r1 < REP_P1; ++r1) {
            if (IN(1)) {
                { pg8::SchedDense S{256, 3, F.G, (int)blockIdx.x, (const char*)(ws + WS_XB), (size_t)256 * 1024 * 2, (const char*)(ws + WS_WIN), (size_t)256 * 1024 * 2};
                  pg8::EpiProj E{(pg8::bf16_t*)(ws + WS_PROJ), args.out};
                  pg8::gemm_phase<pg8::EpiProj, pg8::SchedDense, false>(F.lds, F.wave, 2048, 2048, S, E); }
                { pg8::SchedDense S{256, 16, F.G, (int)blockIdx.x, (const char*)(ws + WS_X8), (size_t)256 * 1024, (const char*)(ws + WS_WING8), (size_t)256 * 1024};
                  pg8::EpiGate8 E{(pg8::bf16_t*)(ws + WS_PROJ)};
                  pg8::gemm_phase<pg8::EpiGate8, pg8::SchedDense, false, true>(F.lds, F.wave, 1024, 1024, S, E); }
            }
            SEAM(1);
        }
        if (IN(2)) { REFRESH(); p1b_norms(F, args); }
        SEAM(2);
        if (IN(3)) { REFRESH(); p2_mixers(F, args); }
        SEAM(3);
    }
    for (int rb = 0; rb < REP_34; ++rb) {
        if (IN(4)) {
            { pg8::SchedDense S{256, 4, F.G, (int)blockIdx.x, (const char*)(ws + WS_OL8), (size_t)256 * 1024, (const char*)(ws + WS_WUVA8), (size_t)256 * 1024};
              pg8::EpiMerge<false> E{(const unsigned char*)proj + pg8::GATE8_OFF, (pg8::bf16_t*)(proj + C_GB), nullptr};
              pg8::gemm_phase<pg8::EpiMerge<false>, pg8::SchedDense, false, true>(F.lds, F.wave, 1024, 1024, S, E); }
            { pg8::SchedDense S{256, 4, F.G, (int)blockIdx.x, (const char*)(ws + WS_YB8), (size_t)256 * 512, (const char*)(ws + WS_WB8), (size_t)256 * 512};
              pg8::EpiMerge<true> E{(const unsigned char*)proj + pg8::GATE8_OFF + 1024, (pg8::bf16_t*)(proj + C_GB), ws + WS_X8};
              pg8::gemm_phase<pg8::EpiMerge<true>, pg8::SchedDense, false, true>(F.lds, F.wave, 512, 512, S, E); }
        }
        SEAM(4);
    }
    for (int rc = 0; rc < REP_56; ++rc) {
        for (int r5 = 0; r5 < REP_5; ++r5) {
            if (IN(5)) {
                pg8::SchedDense S{256, 4, F.G, (int)blockIdx.x, (const char*)(ws + WS_X8), (size_t)256 * 1024, (const char*)(ws + WS_WOUT8), (size_t)256 * 1024};
                pg8::EpiOut E{(const pg8::bf16_t*)(ws + WS_XB), (pg8::bf16_t*)(ws + WS_PRE)};
                pg8::gemm_phase<pg8::EpiOut, pg8::SchedDense, false, true>(F.lds, F.wave, 1024, 1024, S, E);
            }
            SEAM(5);
        }
        if (IN(6)) { REFRESH(); p6_ln1_router(F, args); }
        SEAM(6);
    }
    for (int r7 = 0; r7 < REP_7; ++r7) {
        if (IN(7)) { REFRESH(); p7_convert_dispatch(F, args); }
        SEAM(7);
    }
    for (int r8 = 0; r8 < REP_MOE; ++r8) {
    if (hi > 8 && lo < 10) {
        REFRESH();
        const unsigned char* teg = (const unsigned char*)(ws + WS_TE);
        for (int i = F.tid; i < NTE; i += 512) F.lds[TE_LDS + i] = teg[i];
        __syncthreads();
    }
    int total_tiles = __builtin_amdgcn_readfirstlane((int)__hip_atomic_load((const unsigned*)(ws + WS_PST) + 32, RLX_AGENT)) >> 8;
    if (total_tiles > HCAP_TILES) { total_tiles = HCAP_TILES; if (F.wave == 0 && lane_now() == 0) __hip_atomic_store(F.ctl + CW_ERR, 1u, RLX_AGENT); }
#ifndef REP_GU
#define REP_GU 1
#endif
#ifndef REP_DN
#define REP_DN 1
#endif
    for (int rgu = 0; rgu < REP_GU; ++rgu) {
    if (IN(8)) {
        pg8::SchedMoe<8, true> S; S.nM = total_tiles; S.tile0 = 0; S.te = (const PG8_LAS unsigned char*)(F.lds + TE_LDS);
        S.A = (const char*)(ws + WS_X1Q); S.B = (const char*)(ws + WS_WGU); S.toks = (const int*)(ws + WS_TOKS);
        pg8::EpiGU E{args.in[I_BG], args.in[I_BU], ws + WS_H};
        pg8::gemm_phase<pg8::EpiGU, pg8::SchedMoe<8, true>, true, true, MOE_ALIGN>(F.lds, F.wave, 1024, 1024, S, E);
    }
    SEAM(8);
    }
    for (int rdn = 0; rdn < REP_DN; ++rdn) {
    if (IN(9)) {
        pg8::SchedMoe<4, false> S; S.nM = total_tiles; S.tile0 = 0; S.te = (const PG8_LAS unsigned char*)(F.lds + TE_LDS);
        S.A = (const char*)(ws + WS_H); S.B = (const char*)(ws + WS_WD); S.toks = (const int*)(ws + WS_TOKS);
        pg8::EpiDown E{args.in[I_BD], (const float*)(ws + WS_GATES), (const int*)(ws + WS_SLOTS), ws + WS_Y};
        pg8::gemm_phase<pg8::EpiDown, pg8::SchedMoe<4, false>, false, true, MOE_ALIGN>(F.lds, F.wave, 1024, 1024, S, E);
    }
    SEAM(9);
    }
    }
    if (IN(10)) {
        REFRESH();
        bool poison = (__hip_atomic_load(F.ctl + CW_TMO, RLX_AGENT) != 0u) || (__hip_atomic_load(F.ctl + CW_ERR, RLX_AGENT) != 0u);
        for (int li = 0; li < NPHASE; ++li) poison |= __hip_atomic_load(F.ctl + CW_BAR + li * XCD_BAR_WORDS + XB_TMO, RLX_AGENT) != 0u;
        REFRESH(); p16_ln2(F, args, poison);
    }
#undef IN
#undef SEAM
}

extern "C" void kernel_launch(void* const* d_in, const int* in_sizes, int n_in, void* d_out, int out_size, void* d_ws, size_t ws_size, hipStream_t stream) {
    static int grid = 0;
    if (grid == 0) {
        if (n_in != 23 || in_sizes[0] != NTOK * DM || out_size != NTOK * DM || ws_size < WS_END) { fprintf(stderr, "kernel_launch: unexpected shapes (n_in %d, in0 %d, out %d, ws %zu)\n", n_in, n_in > 0 ? in_sizes[0] : -1, out_size, ws_size); grid = -1; return; }
        int dev = 0, cus = 0;
        if (hipGetDevice(&dev) != hipSuccess || hipDeviceGetAttribute(&cus, hipDeviceAttributeMultiprocessorCount, dev) != hipSuccess) { grid = -1; return; }
        if (hipFuncSetAttribute((const void*)mk_fwd, hipFuncAttributeMaxDynamicSharedMemorySize, LDS_BYTES) != hipSuccess) { fprintf(stderr, "kernel_launch: hipFuncSetAttribute failed\n"); grid = -1; return; }
        int per_cu = 0;
        if (hipOccupancyMaxActiveBlocksPerMultiprocessor(&per_cu, (const void*)mk_fwd, 512, LDS_BYTES) != hipSuccess || per_cu < 1) fprintf(stderr, "kernel_launch: occupancy query reports %d\n", per_cu);
        (void)hipGetLastError();
        grid = cus;
    }
    if (grid < 0) return;
    if (hipMemsetAsync((char*)d_ws + WS_CTL, 0, CTL_ZERO_BYTES, stream) != hipSuccess) return;
    Args a{};
    for (int i = 0; i < 23; ++i) a.in[i] = (const float*)d_in[i];
    a.out = (float*)d_out; a.ws = (unsigned char*)d_ws;
#if MK_ONE_LAUNCH
    a.ph_lo = 0; a.ph_hi = NPHASE; a.li = 0; a.pad = 0;
    hipLaunchKernelGGL(mk_fwd, dim3(grid), dim3(512), LDS_BYTES, stream, a);
#else
    for (int ph = 0; ph < NPHASE; ++ph) { a.ph_lo = ph; a.ph_hi = ph + 1; a.li = ph; a.pad = 0; hipLaunchKernelGGL(mk_fwd, dim3(grid), dim3(512), LDS_BYTES, stream, a); }
#endif
}
```
